# Optimizing an MI355X kernel written in HIP

```python
import jax, jax.numpy as jnp
from jax import lax
import numpy as np

D_MODEL = 1024
BATCH = 8
SEQ = 8192
DEPTH = 1

CHUNK = 64
EPS = 1e-6
ADA_SLOTS = 9
N_NORMS = 6
D_FF = 2816
FFN_RES_W = 0.5
CONV_WIDTH = D_MODEL
CONV_K = 3
HG_HEADS = 8
HG_DK = D_MODEL // HG_HEADS
HG_DV = D_MODEL // HG_HEADS
HG_WIDTH = HG_HEADS * HG_DK
N_BRANCH = 2
MIX_WIDTHS = (CONV_WIDTH, CONV_WIDTH, CONV_WIDTH,
              HG_WIDTH, HG_WIDTH, HG_WIDTH, HG_WIDTH,
              D_MODEL, D_MODEL)
MIX_IN = sum(MIX_WIDTHS)
MIX_SPLITS = tuple(int(v) for v in np.cumsum(MIX_WIDTHS)[:-1])

kernel_name = "hybrid_conv_hgrn2_macaron_block"


def _rmsnorm(x, g):
    xf = x.astype(jnp.float32)
    xf = xf * lax.rsqrt(jnp.mean(xf * xf, axis=-1, keepdims=True) + EPS)
    return (xf * g.astype(jnp.float32)).astype(x.dtype)


def _modulate(h, shift, scale):
    return h * (1.0 + scale[:, None, :]) + shift[:, None, :]


def _swiglu(h, w_in, w_out):
    a, b = jnp.split(h @ w_in, 2, axis=-1)
    return (jax.nn.silu(a) * b) @ w_out


def _short_conv(u, w, b):
    s = u.shape[1]
    up = jnp.pad(u, ((0, 0), (CONV_K - 1, 0), (0, 0)))
    y = b[None, None, :]
    for j in range(CONV_K):
        y = y + w[j][None, None, :] * up[:, j:j + s, :]
    return y


def _to_chunks(t):
    b, s, h, d = t.shape
    return t.reshape(b, s // CHUNK, CHUNK, h, d).transpose(1, 0, 3, 2, 4)


def _hgrn2_chunkwise(q, k, v, log_f):
    bsz, s, h, _ = q.shape
    qc, kc, vc = _to_chunks(q), _to_chunks(k), _to_chunks(v)
    ac = jnp.cumsum(_to_chunks(log_f), axis=3)
    causal = jnp.tril(jnp.ones((CHUNK, CHUNK), dtype=bool))[:, :, None]

    def step(state, inp):
        q_i, k_i, v_i, a_i = inp
        o_inter = jnp.einsum('bhtk,bhkv->bhtv', q_i * jnp.exp(a_i), state)
        diff = a_i[:, :, :, None, :] - a_i[:, :, None, :, :]
        decay = jnp.exp(jnp.where(causal, diff, -jnp.inf))
        scores = jnp.einsum('bhtk,bhtsk,bhsk->bhts', q_i, decay, k_i)
        o_intra = jnp.einsum('bhts,bhsv->bhtv', scores, v_i)
        a_last = a_i[:, :, -1:, :]
        k_dec = k_i * jnp.exp(a_last - a_i)
        state = (jnp.exp(a_last[:, :, 0, :])[..., None] * state
                 + jnp.einsum('bhsk,bhsv->bhkv', k_dec, v_i))
        return state, o_inter + o_intra

    s0 = jnp.zeros((bsz, h, HG_DK, HG_DV), jnp.float32)
    _, oc = lax.scan(step, s0, (qc, kc, vc, ac))
    return oc.transpose(1, 0, 3, 2, 4).reshape(bsz, s, h, HG_DV)


def _mixer(h, w_mix_in, conv_w, conv_b, w_conv_out, hg_norm_g, lb, w_hg_out, w_mix_out):
    bsz, s, _ = h.shape
    u = h @ w_mix_in
    cb, cc, cv, hq, hf, hi, hg, ga, gb = jnp.split(u, MIX_SPLITS, axis=-1)

    ya = (cb * _short_conv(cc * cv, conv_w, conv_b)) @ w_conv_out

    hf32 = hf.astype(jnp.float32)
    lb32 = lb.astype(jnp.float32)
    log_f = jnp.logaddexp(jnp.log(lb32), jnp.log1p(-lb32) + jax.nn.log_sigmoid(hf32))
    k = -jnp.expm1(log_f)
    q = jax.nn.silu(hq.astype(jnp.float32))
    shp = (bsz, s, HG_HEADS, HG_DK)
    o = _hgrn2_chunkwise(q.reshape(shp), k.reshape(shp),
                         hi.astype(jnp.float32).reshape(bsz, s, HG_HEADS, HG_DV),
                         log_f.reshape(shp))
    o = _rmsnorm(o, hg_norm_g.reshape(HG_HEADS, HG_DV)).reshape(bsz, s, HG_WIDTH)
    o = (o * jax.nn.silu(hg.astype(jnp.float32))).astype(h.dtype)
    yb = o @ w_hg_out

    m = jax.nn.sigmoid(ga) * ya + jax.nn.sigmoid(gb) * yb
    return m @ w_mix_out


def setup_inputs(seed: int = 0) -> dict:
    key = jax.random.key(seed)
    ks = jax.random.split(key, 17)
    L, D = DEPTH, D_MODEL

    def nrm(k, shape, scale):
        return jax.random.normal(k, shape, jnp.float32) * scale

    return {
        "x": nrm(ks[0], (BATCH, SEQ, D), 1.0),
        "c": nrm(ks[1], (BATCH, D), 1.0),
        "w_ada": nrm(ks[2], (L, D, ADA_SLOTS * D), D ** -0.5),
        "b_ada": nrm(ks[3], (L, ADA_SLOTS * D), 0.02),
        "norm_gains": 1.0 + nrm(ks[4], (L, N_NORMS, D), 0.05),
        "w_ffn1_in": nrm(ks[5], (L, D, 2 * D_FF), D ** -0.5),
        "w_ffn1_out": nrm(ks[6], (L, D_FF, D), D_FF ** -0.5),
        "w_mix_in": nrm(ks[7], (L, D, MIX_IN), D ** -0.5),
        "conv_w": nrm(ks[8], (L, CONV_K, CONV_WIDTH), CONV_K ** -0.5),
        "conv_b": nrm(ks[9], (L, CONV_WIDTH), 0.02),
        "w_conv_out": nrm(ks[10], (L, CONV_WIDTH, D), CONV_WIDTH ** -0.5),
        "hg_norm_g": 1.0 + nrm(ks[11], (L, HG_WIDTH), 0.05),
        "lb_logits": nrm(ks[12], (L + 1, HG_WIDTH), 1.0),
        "w_hg_out": nrm(ks[13], (L, HG_WIDTH, D), HG_WIDTH ** -0.5),
        "w_mix_out": nrm(ks[14], (L, D, D), D ** -0.5),
        "w_ffn2_in": nrm(ks[15], (L, D, 2 * D_FF), D ** -0.5),
        "w_ffn2_out": nrm(ks[16], (L, D_FF, D), D_FF ** -0.5),
    }


def reference(x, c, w_ada, b_ada, norm_gains, w_ffn1_in, w_ffn1_out, w_mix_in, conv_w,
              conv_b, w_conv_out, hg_norm_g, lb_logits, w_hg_out, w_mix_out,
              w_ffn2_in, w_ffn2_out):
    lb_all = jnp.cumsum(jax.nn.softmax(lb_logits.astype(jnp.float32), axis=0), axis=0)
    lb_all = lb_all.astype(x.dtype)
    c_act = jax.nn.silu(c)
    for l in range(DEPTH):
        ada = c_act @ w_ada[l] + b_ada[l]
        sh1, sc1, g1, sh2, sc2, g2, sh3, sc3, g3 = jnp.split(ada, ADA_SLOTS, axis=-1)
        ng = norm_gains[l]

        h = _modulate(_rmsnorm(x, ng[0]), sh1, sc1)
        y = _rmsnorm(_swiglu(h, w_ffn1_in[l], w_ffn1_out[l]), ng[1])
        x = x + FFN_RES_W * g1[:, None, :] * y

        h = _modulate(_rmsnorm(x, ng[2]), sh2, sc2)
        y = _mixer(h, w_mix_in[l], conv_w[l], conv_b[l], w_conv_out[l], hg_norm_g[l],
                   lb_all[l], w_hg_out[l], w_mix_out[l])
        y = _rmsnorm(y, ng[3])
        x = x + g2[:, None, :] * y

        h = _modulate(_rmsnorm(x, ng[4]), sh3, sc3)
        y = _rmsnorm(_swiglu(h, w_ffn2_in[l], w_ffn2_out[l]), ng[5])
        x = x + FFN_RES_W * g3[:, None, :] * y
    return x
```

```cpp
#include <hip/hip_runtime.h>
#include <hip/hip_cooperative_groups.h>
#include <cstdio>
#include <cstdint>
namespace cg = cooperative_groups;

#define LAS __attribute__((address_space(3)))
#define GAS __attribute__((address_space(1)))
template <class T> __device__ __forceinline__ T* as_global(T* p) { unsigned long long u = (unsigned long long)p; asm volatile("" : "+s"(u)); return (T*)(GAS T*)u; }
typedef unsigned short bf16_t;
typedef short bf16x8 __attribute__((ext_vector_type(8)));
typedef short s16x4 __attribute__((ext_vector_type(4)));
typedef float f32x4 __attribute__((ext_vector_type(4)));
typedef float f32x2 __attribute__((ext_vector_type(2)));
typedef unsigned u32x4 __attribute__((ext_vector_type(4)));
typedef unsigned u32x2 __attribute__((ext_vector_type(2)));

constexpr int D = 1024, NB = 8, SEQ = 8192, M = NB * SEQ, FF = 2816, NMIX = 9216;
constexpr int NG = 2, SG = SEQ / NG, MG = NB * SG, CH = 64, NCH = SG / CH;
constexpr float EPS = 1e-6f;
constexpr int NTHREADS = 512, NWAVES = 8;

constexpr size_t MiB = 1u << 20;
constexpr size_t WS_ADA = 0;
constexpr size_t WS_LB = 320 * 1024;
constexpr size_t WS_HALO = 384 * 1024;
constexpr size_t WS_PLOC = 512 * 1024;
constexpr size_t WS_SBUF = 1 * MiB;
constexpr size_t WS_CTL = 5 * MiB, CTL_BYTES = 65536;
constexpr size_t WS_W1IN = 6 * MiB, WS_W1OUT = 17 * MiB, WS_WMIX = 23 * MiB, WS_WCO = 41 * MiB, WS_WHO = 43 * MiB, WS_WMO = 45 * MiB, WS_W2IN = 47 * MiB, WS_W2OUT = 58 * MiB;
constexpr size_t WS_H1 = 64 * MiB, WS_ACT1 = 192 * MiB, WS_Y1 = 544 * MiB;
constexpr size_t WS_H2 = 64 * MiB;
constexpr size_t WS_CB = 192 * MiB, WS_P = 256 * MiB, WS_Q = 320 * MiB, WS_LF = 384 * MiB, WS_V = 448 * MiB, WS_GS = 512 * MiB, WS_SA = 576 * MiB, WS_SB = 640 * MiB, WS_O = 704 * MiB, WS_KK = 832 * MiB;
constexpr size_t WS_XB = 896 * MiB;
constexpr size_t WS_H3 = 192 * MiB, WS_ACT2 = 320 * MiB, WS_Y2 = 672 * MiB;
constexpr size_t WS_END = 1024 * MiB;

constexpr int LDS_BYTES = 158 * 1024;
constexpr int MISC_OFF = LDS_BYTES - 64;

__device__ __forceinline__ float bf2f(unsigned b) { return __uint_as_float(b << 16); }
__device__ __forceinline__ float bflo(unsigned w) { return __uint_as_float(w << 16); }
__device__ __forceinline__ float bfhi(unsigned w) { return __uint_as_float(w & 0xffff0000u); }
typedef __bf16 bf16v2 __attribute__((ext_vector_type(2)));
__device__ __forceinline__ unsigned cvt_pk_bf16(float lo, float hi) { const f32x2 v = {lo, hi}; const bf16v2 r = __builtin_convertvector(v, bf16v2); return __builtin_bit_cast(unsigned, r); }
__device__ __forceinline__ float fsigmoid(float x) { return __builtin_amdgcn_rcpf(1.0f + __expf(-x)); }
__device__ __forceinline__ float fsilu(float x) { return x * fsigmoid(x); }
__device__ __forceinline__ float wave_sum(float v) {
#pragma unroll
    for (int o = 1; o < 64; o <<= 1) v += __shfl_xor(v, o);
    return v;
}

namespace pg8 {
constexpr int BM = 256, BK = 64, HALF = 128, HTB = HALF * BK * 2, STAGE_BYTES = 8 * HTB, NXCD = 8, WGM = 4;
__host__ __device__ __forceinline__ int lds_byte(int r, int c) { const int st = (r >> 4) * 2 + (c >> 5), rr = r & 15, cc = c & 31, ob = rr * 64 + cc * 2; return st * 1024 + (ob ^ (((ob >> 9) & 1) << 5)); }
__host__ __device__ __forceinline__ void stage_rc(int b, int& R, int& C) { const int st = b / 1024, sb = b % 1024, swz = sb ^ (((sb >> 9) & 1) << 5); R = (st >> 1) * 16 + swz / 64; C = (st & 1) * 32 + (swz % 64) / 2; }
__host__ __device__ __forceinline__ int perm32(int rho) { const int n = rho >> 4, i = rho & 15; return 8 * (i >> 2) + 4 * n + (i & 3); }

struct Unit { int pm, pn; };
struct Gemm { const bf16_t* A; const bf16_t* Bt; int M, N, K; };

struct StaticOrder {
    int nM, nN, nwg, G, c;
    __host__ __device__ void init(int M_, int N_, int G_, int c_) { nM = M_ / BM; nN = N_ / BM; nwg = nM * nN; G = G_; c = c_; }
    __host__ __device__ bool next(int i, Unit& u) const {
        const long L = (long)i * G + c; if (L >= nwg) return false;
        int wgid = (int)L; { const int q = nwg / NXCD, r = nwg % NXCD, xcd = wgid % NXCD, off = wgid / NXCD; wgid = (xcd < r ? xcd * (q + 1) : r * (q + 1) + (xcd - r) * q) + off; }
        const int nig = WGM * nN, gid = wgid / nig, fm = gid * WGM, gsz = (nM - fm) < WGM ? (nM - fm) : WGM;
        u.pm = fm + ((wgid % nig) % gsz); u.pn = (wgid % nig) / gsz; return true;
    }
};

template <class Epi>
__device__ __forceinline__ void gemm_phase(LAS unsigned char* lds, const Gemm g, const StaticOrder& S, const Epi& E, const int tid) {
    const int wid = __builtin_amdgcn_readfirstlane(tid >> 6), lane = tid & 63, wr = wid >> 2, wc = wid & 3, fr = lane & 15, fq = lane >> 4;
    const int K = g.K, nt = K / BK;
    unsigned voffA[2], voffB[2];
#pragma unroll
    for (int i = 0; i < 2; ++i) { int R, C; stage_rc(tid * 16 + i * 8192, R, C); const int Rb = ((R & ~31) + perm32(R & 31));
        voffA[i] = (unsigned)(R * K + C) * 2u; voffB[i] = (unsigned)(Rb * K + C) * 2u; }
    const size_t kstep = (size_t)(BK * 2);
    const size_t hstep = (size_t)HALF * K * 2;
    const size_t tstep = 2 * hstep;
    const unsigned ldsw = (unsigned)wid * 1024u;
    const int aoff = lds_byte(wr * 64 + fr, fq * 8), boff = lds_byte(wc * 32 + fr, fq * 8);
#define PG8_SA(b, h) (((b) * 2 + (h)) * HTB)
#define PG8_SB(b, h) ((4 + (b) * 2 + (h)) * HTB)
#define PG8_STAGE(bufoff, gbase, voff) do { _Pragma("unroll") for (int _i = 0; _i < 2; ++_i) \
        __builtin_amdgcn_global_load_lds((const unsigned*)((const char*)(gbase) + (voff)[_i]), (LAS unsigned*)(lds + (bufoff) + ldsw + _i * 8192), 16, 0, 0); } while (0)
#define PG8_LDA(dst, b, h) do { _Pragma("unroll") for (int m = 0; m < 4; ++m) _Pragma("unroll") for (int k = 0; k < 2; ++k) dst[m][k] = *(const LAS bf16x8*)(lds + PG8_SA(b, h) + aoff + m * 2048 + k * 1024); } while (0)
#define PG8_LDB(dst, b, h) do { _Pragma("unroll") for (int n = 0; n < 2; ++n) _Pragma("unroll") for (int k = 0; k < 2; ++k) dst[n][k] = *(const LAS bf16x8*)(lds + PG8_SB(b, h) + boff + n * 2048 + k * 1024); } while (0)
#define PG8_MMA(ai, bj, At, Bt) do { __builtin_amdgcn_s_setprio(1); _Pragma("unroll") for (int m = 0; m < 4; ++m) _Pragma("unroll") for (int n = 0; n < 2; ++n) _Pragma("unroll") for (int k = 0; k < 2; ++k) \
        acc[ai][bj][m][n] = __builtin_amdgcn_mfma_f32_16x16x32_bf16(Bt[n][k], At[m][k], acc[ai][bj][m][n], 0, 0, 0); __builtin_amdgcn_s_setprio(0); } while (0)
#define PG8_WAIT_V(n) asm volatile("s_waitcnt vmcnt(" #n ")" ::: "memory")
#define PG8_WAIT_L(n) asm volatile("s_waitcnt lgkmcnt(" #n ")" ::: "memory")
#define PG8_BAR __builtin_amdgcn_s_barrier()
#define PG8_SCHED __builtin_amdgcn_sched_barrier(0)
    Unit cur, nxt; int ui = 0;
    if (!S.next(0, cur)) return;
    f32x4 acc[2][2][4][2];
#pragma unroll
    for (int a = 0; a < 2; ++a)
#pragma unroll
        for (int b = 0; b < 2; ++b)
#pragma unroll
            for (int m = 0; m < 4; ++m)
#pragma unroll
                for (int n = 0; n < 2; ++n) acc[a][b][m][n] = (f32x4){0.f, 0.f, 0.f, 0.f};
    bf16x8 At[4][2], B0[2][2], B1[2][2];
    const char* cA = (const char*)g.A + (size_t)cur.pm * tstep; const char* cB = (const char*)g.Bt + (size_t)cur.pn * tstep;
    PG8_STAGE(PG8_SB(0, 0), cB, voffB); PG8_STAGE(PG8_SB(0, 1), cB + hstep, voffB); PG8_STAGE(PG8_SA(0, 0), cA, voffA); PG8_STAGE(PG8_SA(0, 1), cA + hstep, voffA);
    if (wr == 1) PG8_BAR;
    PG8_WAIT_V(2); PG8_BAR;
    PG8_STAGE(PG8_SB(1, 0), cB + kstep, voffB); PG8_STAGE(PG8_SA(1, 0), cA + kstep, voffA); PG8_STAGE(PG8_SB(1, 1), cB + hstep + kstep, voffB);
    PG8_WAIT_V(6); PG8_BAR;
    for (;;) {
        const bool has_next = S.next(ui + 1, nxt);
        const char* nA = has_next ? (const char*)g.A + (size_t)nxt.pm * tstep : cA; const char* nB = has_next ? (const char*)g.Bt + (size_t)nxt.pn * tstep : cB;
        for (int t = 0; t < nt; t += 2) {
            const bool last = (t == nt - 2);
            const char* a1 = cA + (size_t)(t + 1) * kstep;
            const char* a2 = last ? nA : cA + (size_t)(t + 2) * kstep; const char* b2 = last ? nB : cB + (size_t)(t + 2) * kstep;
            const char* a3 = a2 + kstep; const char* b3 = b2 + kstep;
            PG8_LDB(B0, 0, 0); PG8_LDB(B1, 0, 1); PG8_SCHED; PG8_LDA(At, 0, 0); PG8_STAGE(PG8_SA(1, 1), a1 + hstep, voffA);
            PG8_WAIT_V(8); PG8_WAIT_L(0); PG8_BAR; PG8_MMA(0, 0, At, B0); PG8_MMA(0, 1, At, B1); PG8_BAR; PG8_SCHED;
            PG8_LDA(At, 0, 1); PG8_STAGE(PG8_SB(0, 0), b2, voffB); PG8_STAGE(PG8_SB(0, 1), b2 + hstep, voffB); PG8_STAGE(PG8_SA(0, 0), a2, voffA);
            PG8_WAIT_V(8); PG8_WAIT_L(0); PG8_BAR; PG8_MMA(1, 0, At, B0); PG8_MMA(1, 1, At, B1); PG8_BAR; PG8_SCHED;
            PG8_LDB(B0, 1, 0); PG8_LDB(B1, 1, 1); PG8_SCHED; PG8_LDA(At, 1, 0); PG8_STAGE(PG8_SA(0, 1), a2 + hstep, voffA);
            PG8_WAIT_V(8); PG8_WAIT_L(0); PG8_BAR; PG8_MMA(0, 0, At, B0); PG8_MMA(0, 1, At, B1); PG8_BAR; PG8_SCHED;
            PG8_LDA(At, 1, 1); PG8_STAGE(PG8_SB(1, 0), b3, voffB); PG8_STAGE(PG8_SB(1, 1), b3 + hstep, voffB); PG8_STAGE(PG8_SA(1, 0), a3, voffA);
            PG8_WAIT_V(8); PG8_WAIT_L(0); PG8_BAR; PG8_MMA(1, 0, At, B0); PG8_MMA(1, 1, At, B1); PG8_BAR; PG8_SCHED;
        }
        if (wr == 0) PG8_BAR;
        E(acc, cur, wr, wc, fr, fq);
        if (!has_next) break;
#pragma unroll
        for (int a = 0; a < 2; ++a)
#pragma unroll
            for (int b = 0; b < 2; ++b)
#pragma unroll
                for (int m = 0; m < 4; ++m)
#pragma unroll
                    for (int n = 0; n < 2; ++n) acc[a][b][m][n] = (f32x4){0.f, 0.f, 0.f, 0.f};
        cur = nxt; cA = nA; cB = nB; ++ui;
        if (wr == 1) PG8_BAR;
    }
    PG8_WAIT_V(0);
    PG8_BAR;
#undef PG8_SA
#undef PG8_SB
#undef PG8_STAGE
#undef PG8_LDA
#undef PG8_LDB
#undef PG8_MMA
#undef PG8_WAIT_V
#undef PG8_WAIT_L
#undef PG8_BAR
#undef PG8_SCHED
}

typedef f32x4 AccT[2][2][4][2];

struct EpiStore {
    bf16_t* O; int ldc;
    __device__ __forceinline__ void operator()(const AccT& acc, const Unit& u, int wr, int wc, int fr, int fq) const {
        const int row0 = u.pm * BM + wr * 64 + fr, col0 = u.pn * BM + wc * 32 + 8 * fq;
#pragma unroll
        for (int ai = 0; ai < 2; ++ai)
#pragma unroll
            for (int m = 0; m < 4; ++m) { bf16_t* rowp = O + (size_t)(row0 + ai * HALF + m * 16) * ldc + col0;
#pragma unroll
                for (int bj = 0; bj < 2; ++bj) { const f32x4 v0 = acc[ai][bj][m][0], v1 = acc[ai][bj][m][1];
                    u32x4 w; w.x = cvt_pk_bf16(v0[0], v0[1]); w.y = cvt_pk_bf16(v0[2], v0[3]); w.z = cvt_pk_bf16(v1[0], v1[1]); w.w = cvt_pk_bf16(v1[2], v1[3]);
                    __builtin_nontemporal_store(w, (u32x4*)(rowp + bj * HALF)); } }
    }
};
struct EpiSwiGLU {
    bf16_t* O; int ldc;
    __device__ __forceinline__ void operator()(const AccT& acc, const Unit& u, int wr, int wc, int fr, int fq) const {
        const int row0 = u.pm * BM + wr * 64 + fr, col0 = u.pn * HALF + wc * 32 + 8 * fq;
#pragma unroll
        for (int ai = 0; ai < 2; ++ai)
#pragma unroll
            for (int m = 0; m < 4; ++m) { bf16_t* rowp = O + (size_t)(row0 + ai * HALF + m * 16) * ldc + col0;
                float r[8];
#pragma unroll
                for (int n = 0; n < 2; ++n)
#pragma unroll
                    for (int j = 0; j < 4; ++j) { const float a = acc[ai][0][m][n][j], b = acc[ai][1][m][n][j]; r[n * 4 + j] = fsilu(a) * b; }
                u32x4 w; w.x = cvt_pk_bf16(r[0], r[1]); w.y = cvt_pk_bf16(r[2], r[3]); w.z = cvt_pk_bf16(r[4], r[5]); w.w = cvt_pk_bf16(r[6], r[7]);
                __builtin_nontemporal_store(w, (u32x4*)rowp); }
    }
};
template <int MODE> struct EpiGate {
    bf16_t* SA; const bf16_t* SB;
    __device__ __forceinline__ void operator()(const AccT& acc, const Unit& u, int wr, int wc, int fr, int fq) const {
        const int row0 = u.pm * BM + wr * 64 + fr, col0 = u.pn * BM + wc * 32 + 8 * fq;
#pragma unroll
        for (int ai = 0; ai < 2; ++ai)
#pragma unroll
            for (int m = 0; m < 4; ++m) { const size_t off = (size_t)(row0 + ai * HALF + m * 16) * D + col0;
#pragma unroll
                for (int bj = 0; bj < 2; ++bj) { const f32x4 v0 = acc[ai][bj][m][0], v1 = acc[ai][bj][m][1];
                    const u32x4 s = *(const u32x4*)(SA + off + bj * HALF);
                    float r[8];
                    if (MODE == 0) {
                        r[0] = bflo(s.x) * v0[0]; r[1] = bfhi(s.x) * v0[1]; r[2] = bflo(s.y) * v0[2]; r[3] = bfhi(s.y) * v0[3];
                        r[4] = bflo(s.z) * v1[0]; r[5] = bfhi(s.z) * v1[1]; r[6] = bflo(s.w) * v1[2]; r[7] = bfhi(s.w) * v1[3];
                    } else {
                        const u32x4 t = *(const u32x4*)(SB + off + bj * HALF);
                        r[0] = bflo(s.x) + bflo(t.x) * v0[0]; r[1] = bfhi(s.x) + bfhi(t.x) * v0[1]; r[2] = bflo(s.y) + bflo(t.y) * v0[2]; r[3] = bfhi(s.y) + bfhi(t.y) * v0[3];
                        r[4] = bflo(s.z) + bflo(t.z) * v1[0]; r[5] = bfhi(s.z) + bfhi(t.z) * v1[1]; r[6] = bflo(s.w) + bflo(t.w) * v1[2]; r[7] = bfhi(s.w) + bfhi(t.w) * v1[3];
                    }
                    u32x4 w; w.x = cvt_pk_bf16(r[0], r[1]); w.y = cvt_pk_bf16(r[2], r[3]); w.z = cvt_pk_bf16(r[4], r[5]); w.w = cvt_pk_bf16(r[6], r[7]);
                    *(u32x4*)(SA + off + bj * HALF) = w; } }
    }
};
struct EpiMix {
    bf16_t *CB, *P, *Q, *LF, *V, *GS, *SA, *SB; const float* lb; bf16_t* KK;
    template <int TYPE>
    __device__ __forceinline__ void tile(bf16_t* O, const AccT& acc, int row0, int colbase) const {
#pragma unroll
        for (int bj = 0; bj < 2; ++bj) { const int col = colbase + bj * HALF;
            float lbv[8];
            if (TYPE == 3) { const f32x4 l0 = *(const f32x4*)(lb + col), l1 = *(const f32x4*)(lb + col + 4);
#pragma unroll
                for (int j = 0; j < 4; ++j) { lbv[j] = l0[j]; lbv[4 + j] = l1[j]; } }
#pragma unroll
            for (int ai = 0; ai < 2; ++ai)
#pragma unroll
                for (int m = 0; m < 4; ++m) { float r[8];
#pragma unroll
                    for (int n = 0; n < 2; ++n)
#pragma unroll
                        for (int j = 0; j < 4; ++j) { const float x = acc[ai][bj][m][n][j]; float y;
                            if (TYPE == 0) y = x; else if (TYPE == 1) y = fsilu(x); else if (TYPE == 2) y = fsigmoid(x);
                            else { const float l = lbv[n * 4 + j], sg = fsigmoid(x); y = __logf(l + (1.0f - l) * sg); }
                            r[n * 4 + j] = y; }
                    u32x4 w; w.x = cvt_pk_bf16(r[0], r[1]); w.y = cvt_pk_bf16(r[2], r[3]); w.z = cvt_pk_bf16(r[4], r[5]); w.w = cvt_pk_bf16(r[6], r[7]);
                    __builtin_nontemporal_store(w, (u32x4*)(O + (size_t)(row0 + ai * HALF + m * 16) * D + col)); } }
    }
    __device__ __forceinline__ void operator()(const AccT& acc, const Unit& u, int wr, int wc, int fr, int fq) const {
        const int row0 = u.pm * BM + wr * 64 + fr, pn = u.pn;
        if (pn >= 4 && pn < 12) {
            const int col0 = (pn - 4) * HALF + wc * 32 + 8 * fq;
#pragma unroll
            for (int ai = 0; ai < 2; ++ai)
#pragma unroll
                for (int m = 0; m < 4; ++m) { float r[8];
#pragma unroll
                    for (int n = 0; n < 2; ++n)
#pragma unroll
                        for (int j = 0; j < 4; ++j) r[n * 4 + j] = acc[ai][0][m][n][j] * acc[ai][1][m][n][j];
                    u32x4 w; w.x = cvt_pk_bf16(r[0], r[1]); w.y = cvt_pk_bf16(r[2], r[3]); w.z = cvt_pk_bf16(r[4], r[5]); w.w = cvt_pk_bf16(r[6], r[7]);
                    __builtin_nontemporal_store(w, (u32x4*)(P + (size_t)(row0 + ai * HALF + m * 16) * D + col0)); }
            return;
        }
        const int colbase = (pn & 3) * BM + wc * 32 + 8 * fq;
        if (pn < 4) tile<0>(CB, acc, row0, colbase);
        else if (pn < 16) tile<1>(Q, acc, row0, colbase);
        else if (pn < 20) tile<3>(LF, acc, row0, colbase);
        else if (pn < 24) tile<0>(V, acc, row0, colbase);
        else if (pn < 28) tile<1>(GS, acc, row0, colbase);
        else if (pn < 32) tile<2>(SA, acc, row0, colbase);
        else tile<2>(SB, acc, row0, colbase);
    }
};
}

struct Args { const float* in[17]; float* out; unsigned char* ws; };
enum { I_X = 0, I_C, I_WADA, I_BADA, I_NG, I_W1IN, I_W1OUT, I_WMIX, I_CONVW, I_CONVB, I_WCO, I_HGG, I_LBL, I_WHO, I_WMO, I_W2IN, I_W2OUT };

struct Ctx { int tid, lane, wave, G, bid; unsigned char* ws; };
__device__ __forceinline__ Ctx mkctx(unsigned char* ws_in) {
    Ctx c; int t = threadIdx.x; asm volatile("" : "+v"(t)); c.tid = t; c.lane = t & 63; c.wave = __builtin_amdgcn_readfirstlane(t >> 6);
    int g = gridDim.x; asm volatile("" : "+s"(g)); c.G = g; int b = blockIdx.x; asm volatile("" : "+s"(b)); c.bid = b;
    unsigned char* w = ws_in; asm volatile("" : "+s"(w)); c.ws = as_global(w); return c;
}

__device__ __forceinline__ int map_row(int mode, int n0) {
    if (mode == 1) { const int half = n0 >= FF ? 1 : 0; const int j = n0 - half * FF; return (j >> 7) * 256 + half * 128 + (j & 127); }
    if (mode == 2) { const int s = n0 >> 10, j = n0 & 1023; if (s == 1 || s == 2) return (4 + (j >> 7)) * 256 + (s - 1) * 128 + (j & 127); return n0; }
    return n0;
}
__device__ __forceinline__ void p0_transpose_item(const float* W, int K, int N, bf16_t* WT, int mode, LAS float* scr, int item, int lane) {
    const int nblk = N / 32, kb = item / nblk, nb = item % nblk, k0 = 64 * kb, n0 = 32 * nb;
    const int drow = map_row(mode, n0);
    float wv[32];
#pragma unroll
    for (int i = 0; i < 32; ++i) wv[i] = W[(size_t)(k0 + 2 * i + (lane >> 5)) * N + n0 + (lane & 31)];
#pragma unroll
    for (int i = 0; i < 32; ++i) scr[(2 * i + (lane >> 5)) * 33 + (lane & 31)] = wv[i];
    asm volatile("s_waitcnt lgkmcnt(0)" ::: "memory");
    const int c = lane & 7;
#pragma unroll
    for (int j = 0; j < 4; ++j) { const int n = (lane >> 3) + 8 * j; const LAS float* s = scr + (8 * c) * 33 + n;
        u32x4 o; o.x = cvt_pk_bf16(s[0 * 33], s[1 * 33]); o.y = cvt_pk_bf16(s[2 * 33], s[3 * 33]); o.z = cvt_pk_bf16(s[4 * 33], s[5 * 33]); o.w = cvt_pk_bf16(s[6 * 33], s[7 * 33]);
        *(u32x4*)(WT + (size_t)(drow + n) * K + k0 + 8 * c) = o; }
    asm volatile("s_waitcnt lgkmcnt(0)" ::: "memory");
}

__device__ __forceinline__ void p0_prologue(const Args& a, LAS unsigned char* lds, const Ctx& cx) {
    unsigned char* ws = cx.ws;
    const int G = cx.G, tid = cx.tid, wave = cx.wave, lane = cx.lane, bid = cx.bid;
    {
        LAS float* sc = (LAS float*)lds;
        LAS float* red = (LAS float*)(lds + 32768);
        for (int i = tid; i < NB * D; i += NTHREADS) sc[i] = fsilu(a.in[I_C][i]);
        __syncthreads();
        const float* wada = a.in[I_WADA];
        float* ada = (float*)(ws + WS_ADA);
        for (int nb = bid; nb < 9 * D / 64; nb += G) {
            const int n = nb * 64 + lane, k0 = wave * 128;
            float acc[8];
#pragma unroll
            for (int b = 0; b < 8; ++b) acc[b] = 0.f;
#pragma unroll 16
            for (int kk = 0; kk < 128; ++kk) { const float wv = wada[(size_t)(k0 + kk) * (9 * D) + n];
#pragma unroll
                for (int b = 0; b < 8; ++b) acc[b] += sc[b * D + k0 + kk] * wv; }
#pragma unroll
            for (int b = 0; b < 8; ++b) red[(wave * 8 + b) * 64 + lane] = acc[b];
            __syncthreads();
            { const int b = tid >> 6; float s = 0.f;
#pragma unroll
              for (int w = 0; w < 8; ++w) s += red[(w * 8 + b) * 64 + lane];
              ada[b * (9 * D) + n] = s + a.in[I_BADA][n]; }
            __syncthreads();
        }
    }
    if (bid == G - 1) {
        float* lbo = (float*)(ws + WS_LB); const float* ll = a.in[I_LBL];
        for (int c = tid; c < D; c += NTHREADS) lbo[c] = 1.0f / (1.0f + expf(ll[D + c] - ll[c]));
    }
    __syncthreads();
    LAS float* scr = (LAS float*)(lds + 49152 + wave * 8704);
    const int gw = bid * NWAVES + wave, NGW = G * NWAVES;
    constexpr int I_FI = (D / 64) * (2 * FF / 32), I_FO = (FF / 64) * (D / 32), I_MI = (D / 64) * (NMIX / 32), I_SQ = (D / 64) * (D / 32);
    constexpr int NITEMS = 2 * I_FI + 2 * I_FO + I_MI + 3 * I_SQ;
    for (int it = gw; it < NITEMS; it += NGW) {
        int r = it;
        if (r < I_MI) { p0_transpose_item(a.in[I_WMIX], D, NMIX, (bf16_t*)(ws + WS_WMIX), 2, scr, r, lane); continue; } r -= I_MI;
        if (r < I_FI) { p0_transpose_item(a.in[I_W1IN], D, 2 * FF, (bf16_t*)(ws + WS_W1IN), 1, scr, r, lane); continue; } r -= I_FI;
        if (r < I_FI) { p0_transpose_item(a.in[I_W2IN], D, 2 * FF, (bf16_t*)(ws + WS_W2IN), 1, scr, r, lane); continue; } r -= I_FI;
        if (r < I_FO) { p0_transpose_item(a.in[I_W1OUT], FF, D, (bf16_t*)(ws + WS_W1OUT), 0, scr, r, lane); continue; } r -= I_FO;
        if (r < I_FO) { p0_transpose_item(a.in[I_W2OUT], FF, D, (bf16_t*)(ws + WS_W2OUT), 0, scr, r, lane); continue; } r -= I_FO;
        if (r < I_SQ) { p0_transpose_item(a.in[I_WCO], D, D, (bf16_t*)(ws + WS_WCO), 0, scr, r, lane); continue; } r -= I_SQ;
        if (r < I_SQ) { p0_transpose_item(a.in[I_WHO], D, D, (bf16_t*)(ws + WS_WHO), 0, scr, r, lane); continue; } r -= I_SQ;
        p0_transpose_item(a.in[I_WMO], D, D, (bf16_t*)(ws + WS_WMO), 0, scr, r, lane);
    }
}

__device__ __forceinline__ int gm_row(int m) { return ((m >> 12) & 1) * MG + (m >> 13) * SG + (m & (SG - 1)); }

__device__ __forceinline__ void normmod_phase(const float* x, const float* ng, const float* ada, int shslot, int scslot, bf16_t* H, const Ctx& cx) {
    const int wave = cx.wave, lane = cx.lane; const int gw = cx.bid * NWAVES + wave, NGW = cx.G * NWAVES;
    constexpr int RB = 4;
    for (int m4 = gw; m4 < M / RB; m4 += NGW) {
        const int m0 = m4 * RB, b = m0 >> 13;
        f32x4 v[RB][4];
#pragma unroll
        for (int r = 0; r < RB; ++r) { const f32x4* xr = (const f32x4*)(x + (size_t)(m0 + r) * D) + lane;
#pragma unroll
            for (int j = 0; j < 4; ++j) v[r][j] = xr[64 * j]; }
        float rstd[RB];
#pragma unroll
        for (int r = 0; r < RB; ++r) { float s = 0.f;
#pragma unroll
            for (int j = 0; j < 4; ++j) s += (v[r][j].x * v[r][j].x + v[r][j].y * v[r][j].y) + (v[r][j].z * v[r][j].z + v[r][j].w * v[r][j].w);
            rstd[r] = rsqrtf(wave_sum(s) * (1.f / D) + EPS); }
        const float* sh = ada + (size_t)b * 9 * D + shslot * D; const float* sc = ada + (size_t)b * 9 * D + scslot * D;
#pragma unroll
        for (int j = 0; j < 4; ++j) { const int c = 4 * lane + 256 * j;
            const f32x4 gv = *(const f32x4*)(ng + c), scv = *(const f32x4*)(sc + c), shv = *(const f32x4*)(sh + c);
            const f32x4 mul = gv * (scv + 1.0f);
#pragma unroll
            for (int r = 0; r < RB; ++r) { const f32x4 h = v[r][j] * rstd[r] * mul + shv;
                u32x2 w; w.x = cvt_pk_bf16(h.x, h.y); w.y = cvt_pk_bf16(h.z, h.w); ((u32x2*)(H + (size_t)(m0 + r) * D) + lane)[64 * j] = w; } }
    }
}

template <bool HAS_NEXT, bool Y_GM, bool H_GM, bool XIN_BF, bool XOUT_BF>
__device__ __forceinline__ void res_phase(const bf16_t* Y, const void* xin_, void* xout_, float wres, const float* ada, int gslot, const float* ng_post,
                                          const float* ng_pre, int shslot, int scslot, bf16_t* H, const Ctx& cx) {
    const int wave = cx.wave, lane = cx.lane; const int gw = cx.bid * NWAVES + wave, NGW = cx.G * NWAVES;
    constexpr int RB = XIN_BF ? 4 : 2;
    for (int m4 = gw; m4 < M / RB; m4 += NGW) {
        const int m0 = m4 * RB, b = m0 >> 13;
        const size_t y0 = Y_GM ? (size_t)gm_row(m0) : (size_t)m0;
        u32x2 yw[RB][4]; f32x4 xv[RB][4];
#pragma unroll
        for (int r = 0; r < RB; ++r) { const u32x2* yr = (const u32x2*)(Y + (y0 + r) * D) + lane;
#pragma unroll
            for (int j = 0; j < 4; ++j) { yw[r][j] = yr[64 * j];
                if (XIN_BF) { const u32x2 xw = ((const u32x2*)((const bf16_t*)xin_ + (size_t)(m0 + r) * D) + lane)[64 * j]; xv[r][j] = (f32x4){bflo(xw.x), bfhi(xw.x), bflo(xw.y), bfhi(xw.y)}; }
                else xv[r][j] = ((const f32x4*)((const float*)xin_ + (size_t)(m0 + r) * D) + lane)[64 * j]; } }
        float rstd[RB];
#pragma unroll
        for (int r = 0; r < RB; ++r) { float s = 0.f;
#pragma unroll
            for (int j = 0; j < 4; ++j) { const f32x4 y = (f32x4){bflo(yw[r][j].x), bfhi(yw[r][j].x), bflo(yw[r][j].y), bfhi(yw[r][j].y)}; s += (y.x * y.x + y.y * y.y) + (y.z * y.z + y.w * y.w); }
            rstd[r] = rsqrtf(wave_sum(s) * (1.f / D) + EPS) * wres; }
        const float* gp = ada + (size_t)b * 9 * D + gslot * D;
        float s2[RB];
#pragma unroll
        for (int r = 0; r < RB; ++r) s2[r] = 0.f;
#pragma unroll
        for (int j = 0; j < 4; ++j) { const int c = 4 * lane + 256 * j;
            const f32x4 gn = *(const f32x4*)(gp + c) * *(const f32x4*)(ng_post + c);
#pragma unroll
            for (int r = 0; r < RB; ++r) { const f32x4 y = (f32x4){bflo(yw[r][j].x), bfhi(yw[r][j].x), bflo(yw[r][j].y), bfhi(yw[r][j].y)};
                const f32x4 xn = xv[r][j] + gn * (y * rstd[r]); xv[r][j] = xn;
                if (XOUT_BF) { u32x2 xw; xw.x = cvt_pk_bf16(xn.x, xn.y); xw.y = cvt_pk_bf16(xn.z, xn.w); ((u32x2*)((bf16_t*)xout_ + (size_t)(m0 + r) * D) + lane)[64 * j] = xw; }
                else ((f32x4*)((float*)xout_ + (size_t)(m0 + r) * D) + lane)[64 * j] = xn;
                s2[r] += (xn.x * xn.x + xn.y * xn.y) + (xn.z * xn.z + xn.w * xn.w); } }
        if (HAS_NEXT) {
            float rstd2[RB];
#pragma unroll
            for (int r = 0; r < RB; ++r) rstd2[r] = rsqrtf(wave_sum(s2[r]) * (1.f / D) + EPS);
            const float* sh = ada + (size_t)b * 9 * D + shslot * D; const float* sc = ada + (size_t)b * 9 * D + scslot * D;
            const size_t h0 = H_GM ? (size_t)gm_row(m0) : (size_t)m0;
#pragma unroll
            for (int j = 0; j < 4; ++j) { const int c = 4 * lane + 256 * j;
                const f32x4 gv = *(const f32x4*)(ng_pre + c), scv = *(const f32x4*)(sc + c), shv = *(const f32x4*)(sh + c);
                const f32x4 mul = gv * (scv + 1.0f);
#pragma unroll
                for (int r = 0; r < RB; ++r) { const f32x4 h = xv[r][j] * rstd2[r] * mul + shv;
                    u32x2 w; w.x = cvt_pk_bf16(h.x, h.y); w.y = cvt_pk_bf16(h.z, h.w); ((u32x2*)(H + (h0 + r) * D) + lane)[64 * j] = w; } }
        }
    }
}

__device__ __forceinline__ void conv_phase(bf16_t* CB, const bf16_t* P, bf16_t* HALO, const float* cw, const float* cbias, int g, const Ctx& cx) {
    const int wave = cx.wave, lane = cx.lane; const int gw = cx.bid * NWAVES + wave, NGW = cx.G * NWAVES;
    constexpr int RB = 4;
    for (int r4 = gw; r4 < MG / RB; r4 += NGW) {
        const int r0 = r4 * RB, b = r0 >> 12, t0 = r0 & (SG - 1);
        u32x4 cb[RB][2], p[RB + 2][2];
#pragma unroll
        for (int j = 0; j < 2; ++j) { const int c = 8 * lane + 512 * j;
#pragma unroll
            for (int r = 0; r < RB; ++r) { cb[r][j] = *(const u32x4*)(CB + (size_t)(r0 + r) * D + c); p[r + 2][j] = *(const u32x4*)(P + (size_t)(r0 + r) * D + c); }
            if (t0 >= 2) { p[0][j] = *(const u32x4*)(P + (size_t)(r0 - 2) * D + c); p[1][j] = *(const u32x4*)(P + (size_t)(r0 - 1) * D + c); }
            else if (g > 0) { p[0][j] = *(const u32x4*)(HALO + (size_t)(b * 2 + 0) * D + c); p[1][j] = *(const u32x4*)(HALO + (size_t)(b * 2 + 1) * D + c); }
            else { p[0][j] = (u32x4){0u, 0u, 0u, 0u}; p[1][j] = (u32x4){0u, 0u, 0u, 0u}; } }
        if (g == 0 && t0 == SG - RB) {
#pragma unroll
            for (int j = 0; j < 2; ++j) { const int c = 8 * lane + 512 * j;
                *(u32x4*)(HALO + (size_t)(b * 2 + 0) * D + c) = p[RB][j]; *(u32x4*)(HALO + (size_t)(b * 2 + 1) * D + c) = p[RB + 1][j]; } }
#pragma unroll
        for (int j = 0; j < 2; ++j) { const int c = 8 * lane + 512 * j;
            float w0[8], w1[8], w2[8], bs[8];
#pragma unroll
            for (int h = 0; h < 2; ++h) { const f32x4 a0 = *(const f32x4*)(cw + c + 4 * h), a1 = *(const f32x4*)(cw + D + c + 4 * h), a2 = *(const f32x4*)(cw + 2 * D + c + 4 * h), bb = *(const f32x4*)(cbias + c + 4 * h);
#pragma unroll
                for (int e = 0; e < 4; ++e) { w0[4 * h + e] = a0[e]; w1[4 * h + e] = a1[e]; w2[4 * h + e] = a2[e]; bs[4 * h + e] = bb[e]; } }
#pragma unroll
            for (int r = 0; r < RB; ++r) {
                const unsigned cbw[4] = {cb[r][j].x, cb[r][j].y, cb[r][j].z, cb[r][j].w}, p0w[4] = {p[r + 2][j].x, p[r + 2][j].y, p[r + 2][j].z, p[r + 2][j].w},
                               p1w[4] = {p[r + 1][j].x, p[r + 1][j].y, p[r + 1][j].z, p[r + 1][j].w}, p2w[4] = {p[r][j].x, p[r][j].y, p[r][j].z, p[r][j].w};
                float r8[8];
#pragma unroll
                for (int e = 0; e < 4; ++e) {
                    r8[2 * e] = bflo(cbw[e]) * (w0[2 * e] * bflo(p2w[e]) + w1[2 * e] * bflo(p1w[e]) + w2[2 * e] * bflo(p0w[e]) + bs[2 * e]);
                    r8[2 * e + 1] = bfhi(cbw[e]) * (w0[2 * e + 1] * bfhi(p2w[e]) + w1[2 * e + 1] * bfhi(p1w[e]) + w2[2 * e + 1] * bfhi(p0w[e]) + bs[2 * e + 1]);
                }
                u32x4 w; w.x = cvt_pk_bf16(r8[0], r8[1]); w.y = cvt_pk_bf16(r8[2], r8[3]); w.z = cvt_pk_bf16(r8[4], r8[5]); w.w = cvt_pk_bf16(r8[6], r8[7]);
                *(u32x4*)(CB + (size_t)(r0 + r) * D + c) = w; } }
    }
}

__device__ __forceinline__ void og_phase(const float* O, const bf16_t* GS, const float* gain, bf16_t* OG, const Ctx& cx) {
    const int wave = cx.wave, lane = cx.lane; const int gw = cx.bid * NWAVES + wave, NGW = cx.G * NWAVES;
    constexpr int RB = 4;
    const int c = 16 * lane;
    for (int r4 = gw; r4 < MG / RB; r4 += NGW) {
        const int r0 = r4 * RB;
        f32x4 o[RB][4]; u32x4 gsv[RB][2]; u32x4 ow_[RB][2];
#pragma unroll
        for (int r = 0; r < RB; ++r) { const bf16_t* op = (const bf16_t*)O + (size_t)(r0 + r) * D + c;
            ow_[r][0] = *(const u32x4*)op; ow_[r][1] = *(const u32x4*)(op + 8);
            gsv[r][0] = *(const u32x4*)(GS + (size_t)(r0 + r) * D + c); gsv[r][1] = *(const u32x4*)(GS + (size_t)(r0 + r) * D + c + 8); }
        f32x4 gn[4];
#pragma unroll
        for (int j = 0; j < 4; ++j) gn[j] = *(const f32x4*)(gain + c + 4 * j);
#pragma unroll
        for (int r = 0; r < RB; ++r) { float s = 0.f;
            { const unsigned w8[8] = {ow_[r][0].x, ow_[r][0].y, ow_[r][0].z, ow_[r][0].w, ow_[r][1].x, ow_[r][1].y, ow_[r][1].z, ow_[r][1].w};
#pragma unroll
              for (int j = 0; j < 4; ++j) o[r][j] = (f32x4){bflo(w8[2 * j]), bfhi(w8[2 * j]), bflo(w8[2 * j + 1]), bfhi(w8[2 * j + 1])}; }
#pragma unroll
            for (int j = 0; j < 4; ++j) s += (o[r][j].x * o[r][j].x + o[r][j].y * o[r][j].y) + (o[r][j].z * o[r][j].z + o[r][j].w * o[r][j].w);
            s += __shfl_xor(s, 1); s += __shfl_xor(s, 2); s += __shfl_xor(s, 4);
            const float rstd = rsqrtf(s * (1.f / 128.f) + EPS);
            const unsigned gw4[8] = {gsv[r][0].x, gsv[r][0].y, gsv[r][0].z, gsv[r][0].w, gsv[r][1].x, gsv[r][1].y, gsv[r][1].z, gsv[r][1].w};
            unsigned ow[8];
#pragma unroll
            for (int j = 0; j < 4; ++j) {
                const float a0 = o[r][j].x * rstd * gn[j].x * bflo(gw4[2 * j]), a1 = o[r][j].y * rstd * gn[j].y * bfhi(gw4[2 * j]);
                const float a2 = o[r][j].z * rstd * gn[j].z * bflo(gw4[2 * j + 1]), a3 = o[r][j].w * rstd * gn[j].w * bfhi(gw4[2 * j + 1]);
                ow[2 * j] = cvt_pk_bf16(a0, a1); ow[2 * j + 1] = cvt_pk_bf16(a2, a3); }
            *(u32x4*)(OG + (size_t)(r0 + r) * D + c) = (u32x4){ow[0], ow[1], ow[2], ow[3]};
            *(u32x4*)(OG + (size_t)(r0 + r) * D + c + 8) = (u32x4){ow[4], ow[5], ow[6], ow[7]}; }
    }
}

namespace scan {
constexpr int SQB = 272;
constexpr int SVB = 144;
constexpr int L_QD = 0, L_QT = L_QD + 64 * SQB, L_KT0 = L_QT + 64 * SQB, L_KT1 = L_KT0 + 32 * SQB, L_ST = L_KT1 + 64 * SQB, L_VT = L_ST + 2 * 32 * SQB,
              L_TQ = L_VT + 2 * 32 * SVB, L_TK = L_TQ + 64 * SQB, L_TL = L_TK + 64 * SQB, L_END = L_TL + 64 * SQB;
static_assert(L_END <= MISC_OFF, "scan LDS map");
#define LBAR() do { asm volatile("s_waitcnt lgkmcnt(0)" ::: "memory"); __builtin_amdgcn_s_barrier(); asm volatile("" ::: "memory"); } while (0)
#define MF(a, b, c) __builtin_amdgcn_mfma_f32_16x16x32_bf16((a), (b), (c), 0, 0, 0)

__device__ __forceinline__ void scan_phase(LAS unsigned char* lds, const bf16_t* Qb, const bf16_t* LFb, const bf16_t* KKb, const bf16_t* Vb, float* Ob, float* SBUF, int g, const Ctx& cx) {
    const int tid = cx.tid, w = cx.wave, lane = cx.lane;
    const int l15 = lane & 15, quad = lane >> 4;
    const f32x4 Z4 = (f32x4){0.f, 0.f, 0.f, 0.f};
    for (int unit = cx.bid; unit < 256; unit += cx.G) {
        const int xcd = unit & 7, jj0 = unit >> 3, vs = jj0 & 3, bh = xcd * 8 + (jj0 >> 2), b = bh >> 3, h = bh & 7;
        const size_t rowbase = (size_t)b * SG;
        const int colq = h * 128, colv = h * 128 + vs * 32;
        const int kc = colq + 16 * w + l15;
        const int kr = colq + 16 * w + 4 * quad;
        bf16x8 ONES, M0, M1, SEL;
#pragma unroll
        for (int j = 0; j < 8; ++j) { ONES[j] = (short)0x3F80; M0[j] = (8 * quad + j <= l15) ? (short)0x3F80 : (short)0; M1[j] = (8 * quad + j <= 16 + l15) ? (short)0x3F80 : (short)0; SEL[j] = (quad < 2) ? (short)0x3F80 : (short)0; }
        f32x4 Sacc[2];
        float* sb = SBUF + (size_t)bh * 128 * 128;
#pragma unroll
        for (int vt = 0; vt < 2; ++vt)
#pragma unroll
            for (int j = 0; j < 4; ++j) Sacc[vt][j] = (g == 0) ? 0.f : sb[(16 * w + 4 * quad + j) * 128 + vs * 32 + 16 * vt + l15];
#pragma unroll
        for (int vt = 0; vt < 2; ++vt) { u32x2 sw; sw.x = cvt_pk_bf16(Sacc[vt][0], Sacc[vt][1]); sw.y = cvt_pk_bf16(Sacc[vt][2], Sacc[vt][3]);
            *(LAS u32x2*)(lds + L_ST + (16 * vt + l15) * SQB + (16 * w + 4 * quad) * 2) = sw; }
        u32x4 rq[2], rk[2], rl[2]; u32x2 rv;
        const int vrow = tid >> 3, vvc = tid & 7;
        const int prow0 = tid >> 4, pkc = tid & 15;
        const int pp0 = ((pkc + 2 * (prow0 >> 3)) & 15) * 16, pp1 = ((pkc + 2 * ((prow0 + 32) >> 3)) & 15) * 16;
#define SC_LOAD(c) do { const size_t r0_ = rowbase + (size_t)(c) * CH; \
            rq[0] = *(const u32x4*)(Qb + (r0_ + prow0) * D + colq + 8 * pkc); rq[1] = *(const u32x4*)(Qb + (r0_ + prow0 + 32) * D + colq + 8 * pkc); \
            rk[0] = *(const u32x4*)(KKb + (r0_ + prow0) * D + colq + 8 * pkc); rk[1] = *(const u32x4*)(KKb + (r0_ + prow0 + 32) * D + colq + 8 * pkc); \
            rl[0] = *(const u32x4*)(LFb + (r0_ + prow0) * D + colq + 8 * pkc); rl[1] = *(const u32x4*)(LFb + (r0_ + prow0 + 32) * D + colq + 8 * pkc); \
            rv = *(const u32x2*)(Vb + (r0_ + vrow) * D + colv + 4 * vvc); } while (0)
#define SC_STOREV(c) do { LAS unsigned char* vt_ = lds + L_VT + ((c) & 1) * 32 * SVB + vrow * 2; \
            *(LAS unsigned short*)(vt_ + (4 * vvc + 0) * SVB) = (unsigned short)(rv.x & 0xffffu); *(LAS unsigned short*)(vt_ + (4 * vvc + 1) * SVB) = (unsigned short)(rv.x >> 16); \
            *(LAS unsigned short*)(vt_ + (4 * vvc + 2) * SVB) = (unsigned short)(rv.y & 0xffffu); *(LAS unsigned short*)(vt_ + (4 * vvc + 3) * SVB) = (unsigned short)(rv.y >> 16); \
            *(LAS u32x4*)(lds + L_TQ + prow0 * SQB + pp0) = rq[0]; *(LAS u32x4*)(lds + L_TQ + (prow0 + 32) * SQB + pp1) = rq[1]; \
            *(LAS u32x4*)(lds + L_TK + prow0 * SQB + pp0) = rk[0]; *(LAS u32x4*)(lds + L_TK + (prow0 + 32) * SQB + pp1) = rk[1]; \
            *(LAS u32x4*)(lds + L_TL + prow0 * SQB + pp0) = rl[0]; *(LAS u32x4*)(lds + L_TL + (prow0 + 32) * SQB + pp1) = rl[1]; } while (0)
        bf16x8 LF0, LF1; float kcf[16]; u32x2 qc[4], kc4[4];
#define TCOL(r_, kk_) (((kk_) + 16 * ((r_) >> 3)) & 127)
#define SC_CONSUME() do { const int kl_ = 16 * w + l15, kq_ = 16 * w + 4 * quad; \
            const LAS unsigned short* tl_ = (const LAS unsigned short*)(lds + L_TL); const LAS unsigned short* tk_ = (const LAS unsigned short*)(lds + L_TK); \
            unsigned short l_[16]; \
            _Pragma("unroll") for (int j_ = 0; j_ < 8; ++j_) { l_[j_] = tl_[(8 * quad + j_) * (SQB / 2) + TCOL(8 * quad, kl_)]; l_[8 + j_] = tl_[(32 + 8 * quad + j_) * (SQB / 2) + TCOL(32 + 8 * quad, kl_)]; } \
            _Pragma("unroll") for (int t_ = 0; t_ < 4; ++t_) { _Pragma("unroll") for (int j_ = 0; j_ < 4; ++j_) kcf[4 * t_ + j_] = bf2f((unsigned)tk_[(16 * t_ + 4 * quad + j_) * (SQB / 2) + TCOL(16 * t_ + 4 * quad, kl_)]); \
                qc[t_] = *(const LAS u32x2*)(lds + L_TQ + (16 * t_ + l15) * SQB + TCOL(16 * t_ + l15, kq_) * 2); kc4[t_] = *(const LAS u32x2*)(lds + L_TK + (16 * t_ + l15) * SQB + TCOL(16 * t_ + l15, kq_) * 2); } \
            u32x4 a_, b_; \
            a_.x = (unsigned)l_[0] | ((unsigned)l_[1] << 16); a_.y = (unsigned)l_[2] | ((unsigned)l_[3] << 16); a_.z = (unsigned)l_[4] | ((unsigned)l_[5] << 16); a_.w = (unsigned)l_[6] | ((unsigned)l_[7] << 16); \
            b_.x = (unsigned)l_[8] | ((unsigned)l_[9] << 16); b_.y = (unsigned)l_[10] | ((unsigned)l_[11] << 16); b_.z = (unsigned)l_[12] | ((unsigned)l_[13] << 16); b_.w = (unsigned)l_[14] | ((unsigned)l_[15] << 16); \
            LF0 = __builtin_bit_cast(bf16x8, a_); LF1 = __builtin_bit_cast(bf16x8, b_); } while (0)
        SC_LOAD(0); SC_STOREV(0);
        f32x4 oprev = Z4;
        for (int c = 0; c < NCH; ++c) {
            LBAR();
            { const int cn = (c + 1 < NCH) ? c + 1 : NCH - 1; SC_LOAD(cn); }
            asm volatile("" ::: "memory");
            {
                const int cp = c > 0 ? c - 1 : 0;
                float* op = Ob + (rowbase + (size_t)cp * CH + 16 * (w >> 1) + 4 * quad) * D + colv + 16 * (w & 1) + l15;
#pragma unroll
                for (int j = 0; j < 4; ++j) op[(size_t)j * D] = oprev[j];
            }
            asm volatile("" ::: "memory");
            SC_CONSUME();
            f32x4 aC[4], aR[4], alC, alR, r0, r1;
            {
                const f32x4 X = MF(ONES, LF0, Z4);
                aC[0] = MF(M0, LF0, Z4); aC[1] = MF(M1, LF0, Z4); aC[2] = MF(M0, LF1, X); aC[3] = MF(M1, LF1, X); alC = MF(ONES, LF1, X);
                const f32x4 Y = MF(LF0, ONES, Z4);
                aR[0] = MF(LF0, M0, Z4); aR[1] = MF(LF0, M1, Z4); aR[2] = MF(LF1, M0, Y); aR[3] = MF(LF1, M1, Y); alR = MF(LF1, ONES, Y);
                r0 = MF(LF0, SEL, Z4); r1 = MF(LF1, SEL, Y);
            }
            bf16x8 KdA[2];
            {
                float kd[16];
#pragma unroll
                for (int tt = 0; tt < 4; ++tt)
#pragma unroll
                    for (int j = 0; j < 4; ++j) kd[4 * tt + j] = kcf[4 * tt + j] * __expf(alC[j] - aC[tt][j]);
                u32x4 p0, p1;
                p0.x = cvt_pk_bf16(kd[0], kd[1]); p0.y = cvt_pk_bf16(kd[2], kd[3]); p0.z = cvt_pk_bf16(kd[4], kd[5]); p0.w = cvt_pk_bf16(kd[6], kd[7]);
                p1.x = cvt_pk_bf16(kd[8], kd[9]); p1.y = cvt_pk_bf16(kd[10], kd[11]); p1.z = cvt_pk_bf16(kd[12], kd[13]); p1.w = cvt_pk_bf16(kd[14], kd[15]);
                KdA[0] = __builtin_bit_cast(bf16x8, p0); KdA[1] = __builtin_bit_cast(bf16x8, p1);
            }
            f32x4 dk;
            {
                f32x4 er0, er1, c10;
#pragma unroll
                for (int j = 0; j < 4; ++j) { er0[j] = __expf(r0[j]); er1[j] = __expf(r1[j]); c10[j] = __expf(r1[j] - r0[j]); dk[j] = __expf(alR[j]); }
#pragma unroll
                for (int tt = 0; tt < 4; ++tt) {
                    const f32x4 rI = (tt < 2) ? r0 : r1, erI = (tt < 2) ? er0 : er1;
                    const float qf[4] = {bflo(qc[tt].x), bfhi(qc[tt].x), bflo(qc[tt].y), bfhi(qc[tt].y)}, kf[4] = {bflo(kc4[tt].x), bfhi(kc4[tt].x), bflo(kc4[tt].y), bfhi(kc4[tt].y)};
                    float qd[4], qt[4], kt[4], k1[4];
#pragma unroll
                    for (int j = 0; j < 4; ++j) { const float d = fminf(fmaxf(aR[tt][j] - rI[j], -80.f), 80.f);
                        qt[j] = qf[j] * __expf(d); qd[j] = qt[j] * erI[j]; kt[j] = kf[j] * __expf(-d); k1[j] = kt[j] * c10[j]; }
                    const int off = (16 * tt + l15) * SQB + (16 * w + 4 * quad) * 2;
                    u32x2 wq, wt, wk;
                    wq.x = cvt_pk_bf16(qd[0], qd[1]); wq.y = cvt_pk_bf16(qd[2], qd[3]); wt.x = cvt_pk_bf16(qt[0], qt[1]); wt.y = cvt_pk_bf16(qt[2], qt[3]); wk.x = cvt_pk_bf16(kt[0], kt[1]); wk.y = cvt_pk_bf16(kt[2], kt[3]);
                    *(LAS u32x2*)(lds + L_QD + off) = wq;
                    *(LAS u32x2*)(lds + L_QT + off) = wt;
                    if (tt < 2) { u32x2 w1; w1.x = cvt_pk_bf16(k1[0], k1[1]); w1.y = cvt_pk_bf16(k1[2], k1[3]);
                        *(LAS u32x2*)(lds + L_KT0 + off) = wk; *(LAS u32x2*)(lds + L_KT1 + off) = w1; }
                    else *(LAS u32x2*)(lds + L_KT1 + off) = wk;
                }
            }
            LBAR();
            f32x4 o = Z4;
            const int ti = w >> 1, vt = w & 1;
            {
                const LAS unsigned char* STc = lds + L_ST + (c & 1) * 32 * SQB;
                LAS unsigned char* STn = lds + L_ST + ((c + 1) & 1) * 32 * SQB;
                const LAS unsigned char* VTc = lds + L_VT + (c & 1) * 32 * SVB;
#pragma unroll
                for (int ks = 0; ks < 4; ++ks) {
                    const bf16x8 af = *(const LAS bf16x8*)(lds + L_QD + (16 * ti + l15) * SQB + (8 * quad + 32 * ks) * 2);
                    const bf16x8 bfr = *(const LAS bf16x8*)(STc + (16 * vt + l15) * SQB + (8 * quad + 32 * ks) * 2);
                    o = MF(af, bfr, o);
                }
                f32x4 pT[4];
                const LAS unsigned char* KT = (ti < 2) ? (lds + L_KT0) : (lds + L_KT1);
                bf16x8 qf[4];
#pragma unroll
                for (int ks = 0; ks < 4; ++ks) qf[ks] = *(const LAS bf16x8*)(lds + L_QT + (16 * ti + l15) * SQB + (8 * quad + 32 * ks) * 2);
#pragma unroll
                for (int sj = 0; sj < 4; ++sj) {
                    bf16x8 kf[4];
#pragma unroll
                    for (int ks = 0; ks < 4; ++ks) kf[ks] = *(const LAS bf16x8*)(KT + (16 * sj + l15) * SQB + (8 * quad + 32 * ks) * 2);
                    pT[sj] = Z4;
#pragma unroll
                    for (int ks = 0; ks < 4; ++ks) pT[sj] = MF(kf[ks], qf[ks], pT[sj]);
                }
#pragma unroll
                for (int sj = 0; sj < 4; ++sj)
#pragma unroll
                    for (int j = 0; j < 4; ++j) { const bool keep = (sj < ti) || (sj == ti && 4 * quad + j <= l15); pT[sj][j] = keep ? pT[sj][j] : 0.f; }
#pragma unroll
                for (int pp = 0; pp < 2; ++pp) {
                    u32x4 pa; pa.x = cvt_pk_bf16(pT[2 * pp][0], pT[2 * pp][1]); pa.y = cvt_pk_bf16(pT[2 * pp][2], pT[2 * pp][3]);
                    pa.z = cvt_pk_bf16(pT[2 * pp + 1][0], pT[2 * pp + 1][1]); pa.w = cvt_pk_bf16(pT[2 * pp + 1][2], pT[2 * pp + 1][3]);
                    const LAS unsigned char* vp = VTc + (16 * vt + l15) * SVB + (32 * pp + 4 * quad) * 2;
                    const u32x2 v0 = *(const LAS u32x2*)vp, v1 = *(const LAS u32x2*)(vp + 32);
                    const u32x4 vb = (u32x4){v0.x, v0.y, v1.x, v1.y};
                    o = MF(__builtin_bit_cast(bf16x8, pa), __builtin_bit_cast(bf16x8, vb), o);
                }
#pragma unroll
                for (int v2 = 0; v2 < 2; ++v2) {
#pragma unroll
                    for (int j = 0; j < 4; ++j) Sacc[v2][j] *= dk[j];
#pragma unroll
                    for (int ks = 0; ks < 2; ++ks) {
                        const LAS unsigned char* vp = VTc + (16 * v2 + l15) * SVB + (32 * ks + 4 * quad) * 2;
                        const u32x2 v0 = *(const LAS u32x2*)vp, v1 = *(const LAS u32x2*)(vp + 32);
                        const u32x4 vb = (u32x4){v0.x, v0.y, v1.x, v1.y};
                        Sacc[v2] = MF(KdA[ks], __builtin_bit_cast(bf16x8, vb), Sacc[v2]);
                    }
                    u32x2 sw; sw.x = cvt_pk_bf16(Sacc[v2][0], Sacc[v2][1]); sw.y = cvt_pk_bf16(Sacc[v2][2], Sacc[v2][3]);
                    *(LAS u32x2*)(STn + (16 * v2 + l15) * SQB + (16 * w + 4 * quad) * 2) = sw;
                }
            }
            SC_STOREV(c + 1);
            oprev = o;
        }
        {
            float* op = Ob + (rowbase + (size_t)(NCH - 1) * CH + 16 * (w >> 1) + 4 * quad) * D + colv + 16 * (w & 1) + l15;
#pragma unroll
            for (int j = 0; j < 4; ++j) op[(size_t)j * D] = oprev[j];
        }
        if (g == 0) {
#pragma unroll
            for (int vt = 0; vt < 2; ++vt)
#pragma unroll
                for (int j = 0; j < 4; ++j) sb[(16 * w + 4 * quad + j) * 128 + vs * 32 + 16 * vt + l15] = Sacc[vt][j];
        }
        __syncthreads();
#undef SC_LOAD
#undef SC_STOREV
#undef SC_CONSUME
#undef TCOL
    }
}
}

namespace scan2 {
constexpr int SQB = 272, SVR = 288, NSEG = 4, CPS = NCH / NSEG;
constexpr int L_QD = 0, L_QT = L_QD + 64 * SQB, L_KT0 = L_QT + 64 * SQB, L_KT1 = L_KT0 + 32 * SQB, L_ST = L_KT1 + 64 * SQB, L_VT = L_ST + 128 * SQB,
              L_TQ = L_VT + 64 * SVR, L_TL = L_TQ + 64 * SQB, L_END = L_TL + 64 * SQB;
static_assert(L_END <= MISC_OFF, "scan2 LDS map");
#define LBAR() do { asm volatile("s_waitcnt lgkmcnt(0)" ::: "memory"); __builtin_amdgcn_s_barrier(); asm volatile("" ::: "memory"); } while (0)
#define MF(a, b, c) __builtin_amdgcn_mfma_f32_16x16x32_bf16((a), (b), (c), 0, 0, 0)
#define TCOL(r_, kk_) (((kk_) + 16 * ((r_) >> 3)) & 127)
#define TRR(p_) __builtin_bit_cast(u32x2, __builtin_amdgcn_ds_read_tr16_b64_v4i16((LAS s16x4*)(p_)))

template <bool FULL>
__device__ __forceinline__ void scan_pass(LAS unsigned char* lds, const bf16_t* Qb, const bf16_t* LFb, const bf16_t* KKb, const bf16_t* Vb, float* Ob, float* SBUF, float* SLOC, float* PLOC, int g, const Ctx& cx) {
    const int tid = cx.tid, w = cx.wave, lane = cx.lane;
    const int l15 = lane & 15, quad = lane >> 4;
    const f32x4 Z4 = (f32x4){0.f, 0.f, 0.f, 0.f};
    for (int unit = cx.bid; unit < 256; unit += cx.G) {
        const int xcd = unit & 7, jj0 = unit >> 3, seg = jj0 & 3, bh = xcd * 8 + (jj0 >> 2), b = bh >> 3, h = bh & 7;
        const size_t rowbase = (size_t)b * SG + (size_t)seg * CPS * CH;
        const int colq = h * 128;
        const int kc = colq + 16 * w + l15;
        bf16x8 ONES, M0, M1, SEL;
#pragma unroll
        for (int j = 0; j < 8; ++j) { ONES[j] = (short)0x3F80; M0[j] = (8 * quad + j <= l15) ? (short)0x3F80 : (short)0; M1[j] = (8 * quad + j <= 16 + l15) ? (short)0x3F80 : (short)0; SEL[j] = (quad < 2) ? (short)0x3F80 : (short)0; }
        f32x4 Sacc[8];
        f32x4 sumal = Z4;
        float* sb = SBUF + (size_t)bh * 128 * 128;
        if (FULL) {
#pragma unroll
            for (int vt = 0; vt < 8; ++vt)
#pragma unroll
                for (int j = 0; j < 4; ++j) Sacc[vt][j] = (g == 0) ? 0.f : sb[(16 * w + 4 * quad + j) * 128 + 16 * vt + l15];
            for (int sp = 0; sp < seg; ++sp) {
                const float* sl = SLOC + (size_t)(bh * NSEG + sp) * 128 * 128; const float* pl = PLOC + (size_t)(bh * NSEG + sp) * 128;
                const f32x4 pv = *(const f32x4*)(pl + 16 * w + 4 * quad);
#pragma unroll
                for (int vt = 0; vt < 8; ++vt)
#pragma unroll
                    for (int j = 0; j < 4; ++j) Sacc[vt][j] = pv[j] * Sacc[vt][j] + sl[(16 * w + 4 * quad + j) * 128 + 16 * vt + l15];
            }
#pragma unroll
            for (int vt = 0; vt < 8; ++vt) { u32x2 sw; sw.x = cvt_pk_bf16(Sacc[vt][0], Sacc[vt][1]); sw.y = cvt_pk_bf16(Sacc[vt][2], Sacc[vt][3]);
                *(LAS u32x2*)(lds + L_ST + (16 * vt + l15) * SQB + (16 * w + 4 * quad) * 2) = sw; }
        } else {
#pragma unroll
            for (int vt = 0; vt < 8; ++vt) Sacc[vt] = Z4;
        }
        u32x4 rq[2], rvv[2], rl[2];
#define S2_LOAD(c) do { const size_t r0_ = rowbase + (size_t)(c) * CH; int t2_ = tid; asm volatile("" : "+v"(t2_)); \
            const unsigned toff = (unsigned)((t2_ >> 4) * D + colq + 8 * (t2_ & 15)); \
            const bf16_t* qb_ = Qb + r0_ * D; const bf16_t* vb_ = Vb + r0_ * D; const bf16_t* lb_ = LFb + r0_ * D; \
            if (FULL) { rq[0] = *(const u32x4*)(qb_ + toff); rq[1] = *(const u32x4*)(qb_ + 32 * D + toff); } \
            rvv[0] = *(const u32x4*)(vb_ + toff); rvv[1] = *(const u32x4*)(vb_ + 32 * D + toff); \
            rl[0] = *(const u32x4*)(lb_ + toff); rl[1] = *(const u32x4*)(lb_ + 32 * D + toff); } while (0)
#define S2_STORE(VB_, TB_) do { int t3_ = tid; asm volatile("" : "+v"(t3_)); const int prow0 = t3_ >> 4, pkc = t3_ & 15; \
            const int pp0 = ((pkc + 2 * (prow0 >> 3)) & 15) * 16, pp1 = ((pkc + 2 * ((prow0 + 32) >> 3)) & 15) * 16; \
            *(LAS u32x4*)(lds + (VB_) + prow0 * SVR + pkc * 16) = rvv[0]; *(LAS u32x4*)(lds + (VB_) + (prow0 + 32) * SVR + pkc * 16) = rvv[1]; \
            if (FULL) { *(LAS u32x4*)(lds + L_TQ + prow0 * SQB + pp0) = rq[0]; *(LAS u32x4*)(lds + L_TQ + (prow0 + 32) * SQB + pp1) = rq[1]; } \
            *(LAS u32x4*)(lds + (TB_) + prow0 * SQB + pkc * 16) = rl[0]; *(LAS u32x4*)(lds + (TB_) + (prow0 + 32) * SQB + pkc * 16) = rl[1]; } while (0)
        S2_LOAD(0); S2_STORE(L_VT, L_TL);
        bf16x8 LF0, LF1;
#define S2_LF(TB_) do { const LAS unsigned char* tp_ = lds + (TB_) + (8 * quad + (l15 >> 2)) * SQB + (16 * w + 4 * (l15 & 3)) * 2; \
            const u32x2 x0_ = TRR(tp_), x1_ = TRR(tp_ + 4 * SQB), x2_ = TRR(tp_ + 32 * SQB), x3_ = TRR(tp_ + 36 * SQB); \
            LF0 = __builtin_bit_cast(bf16x8, (u32x4){x0_.x, x0_.y, x1_.x, x1_.y}); LF1 = __builtin_bit_cast(bf16x8, (u32x4){x2_.x, x2_.y, x3_.x, x3_.y}); } while (0)
        const int l15o = l15, quado = quad;
        for (int c = 0; c < CPS; ++c) {
            int l15 = l15o, quad = quado; asm volatile("" : "+v"(l15), "+v"(quad));
            const int vtb = (!FULL && (c & 1)) ? L_QD : L_VT, tlb = (!FULL && (c & 1)) ? (L_QD + 64 * SVR) : L_TL;
            const int vtn = (!FULL && !(c & 1)) ? L_QD : L_VT, tln = (!FULL && !(c & 1)) ? (L_QD + 64 * SVR) : L_TL;
            LBAR();
            { const int cn = (c + 1 < CPS) ? c + 1 : CPS - 1; S2_LOAD(cn); }
            S2_LF(tlb);
            float kcf[16]; u32x2 qc[4], kc4[4];
            {
                const int kl_ = 16 * w + l15, kq_ = 16 * w + 4 * quad;
#pragma unroll
                for (int t_ = 0; t_ < 4; ++t_) {
                    { const int s0_ = 16 * t_ + 4 * quad; const u32x2 kx_ = TRR(lds + tlb + (s0_ + (l15 >> 2)) * SQB + (16 * w + 4 * (l15 & 3)) * 2);
                      kcf[4 * t_ + 0] = 1.0f - __expf(bflo(kx_.x)); kcf[4 * t_ + 1] = 1.0f - __expf(bfhi(kx_.x)); kcf[4 * t_ + 2] = 1.0f - __expf(bflo(kx_.y)); kcf[4 * t_ + 3] = 1.0f - __expf(bfhi(kx_.y)); }
                    if (FULL) { qc[t_] = *(const LAS u32x2*)(lds + L_TQ + (16 * t_ + l15) * SQB + TCOL(16 * t_ + l15, kq_) * 2); kc4[t_] = *(const LAS u32x2*)(lds + tlb + (16 * t_ + l15) * SQB + kq_ * 2); }
                }
            }
            f32x4 aC[4], alC, aR[4], alR, r0 = Z4, r1 = Z4;
            {
                const f32x4 X = MF(ONES, LF0, Z4);
                aC[0] = MF(M0, LF0, Z4); aC[1] = MF(M1, LF0, Z4); aC[2] = MF(M0, LF1, X); aC[3] = MF(M1, LF1, X); alC = MF(ONES, LF1, X);
                const f32x4 Y = MF(LF0, ONES, Z4);
                alR = MF(LF1, ONES, Y);
                if (FULL) { aR[0] = MF(LF0, M0, Z4); aR[1] = MF(LF0, M1, Z4); aR[2] = MF(LF1, M0, Y); aR[3] = MF(LF1, M1, Y); r0 = MF(LF0, SEL, Z4); r1 = MF(LF1, SEL, Y); }
            }
            bf16x8 KdA[2];
            {
                float kd[16];
#pragma unroll
                for (int tt = 0; tt < 4; ++tt)
#pragma unroll
                    for (int j = 0; j < 4; ++j) kd[4 * tt + j] = kcf[4 * tt + j] * __expf(alC[j] - aC[tt][j]);
                u32x4 p0, p1;
                p0.x = cvt_pk_bf16(kd[0], kd[1]); p0.y = cvt_pk_bf16(kd[2], kd[3]); p0.z = cvt_pk_bf16(kd[4], kd[5]); p0.w = cvt_pk_bf16(kd[6], kd[7]);
                p1.x = cvt_pk_bf16(kd[8], kd[9]); p1.y = cvt_pk_bf16(kd[10], kd[11]); p1.z = cvt_pk_bf16(kd[12], kd[13]); p1.w = cvt_pk_bf16(kd[14], kd[15]);
                KdA[0] = __builtin_bit_cast(bf16x8, p0); KdA[1] = __builtin_bit_cast(bf16x8, p1);
            }
            f32x4 dk;
#pragma unroll
            for (int j = 0; j < 4; ++j) dk[j] = __expf(alR[j]);
            sumal = sumal + alR;
            if (FULL) {
                f32x4 er0, er1, c10;
#pragma unroll
                for (int j = 0; j < 4; ++j) { er0[j] = __expf(r0[j]); er1[j] = __expf(r1[j]); c10[j] = __expf(r1[j] - r0[j]); }
#pragma unroll
                for (int tt = 0; tt < 4; ++tt) {
                    const f32x4 rI = (tt < 2) ? r0 : r1, erI = (tt < 2) ? er0 : er1;
                    const float qf[4] = {bflo(qc[tt].x), bfhi(qc[tt].x), bflo(qc[tt].y), bfhi(qc[tt].y)}, kf[4] = {1.0f - __expf(bflo(kc4[tt].x)), 1.0f - __expf(bfhi(kc4[tt].x)), 1.0f - __expf(bflo(kc4[tt].y)), 1.0f - __expf(bfhi(kc4[tt].y))};
                    float qd[4], qt[4], kt[4], k1[4];
#pragma unroll
                    for (int j = 0; j < 4; ++j) { const float d = fminf(fmaxf(aR[tt][j] - rI[j], -80.f), 80.f);
                        qt[j] = qf[j] * __expf(d); qd[j] = qt[j] * erI[j]; kt[j] = kf[j] * __expf(-d); k1[j] = kt[j] * c10[j]; }
                    const int off = (16 * tt + l15) * SQB + (16 * w + 4 * quad) * 2;
                    u32x2 wq, wt, wk;
                    wq.x = cvt_pk_bf16(qd[0], qd[1]); wq.y = cvt_pk_bf16(qd[2], qd[3]); wt.x = cvt_pk_bf16(qt[0], qt[1]); wt.y = cvt_pk_bf16(qt[2], qt[3]); wk.x = cvt_pk_bf16(kt[0], kt[1]); wk.y = cvt_pk_bf16(kt[2], kt[3]);
                    *(LAS u32x2*)(lds + L_QD + off) = wq;
                    *(LAS u32x2*)(lds + L_QT + off) = wt;
                    if (tt < 2) { u32x2 w1; w1.x = cvt_pk_bf16(k1[0], k1[1]); w1.y = cvt_pk_bf16(k1[2], k1[3]);
                        *(LAS u32x2*)(lds + L_KT0 + off) = wk; *(LAS u32x2*)(lds + L_KT1 + off) = w1; }
                    else *(LAS u32x2*)(lds + L_KT1 + off) = wk;
                }
                LBAR();
            }
            const int ti = w >> 1, vh = w & 1;
#pragma unroll
            for (int v2 = 0; v2 < 8; ++v2) {
#pragma unroll
                for (int j = 0; j < 4; ++j) Sacc[v2][j] *= dk[j];
#pragma unroll
                for (int ks = 0; ks < 2; ++ks) { const LAS unsigned char* vp = lds + vtb + (32 * ks + 4 * quad + (l15 >> 2)) * SVR + (16 * v2 + 4 * (l15 & 3)) * 2;
                    const u32x2 v0 = TRR(vp), v1 = TRR(vp + 16 * SVR); const u32x4 vb = (u32x4){v0.x, v0.y, v1.x, v1.y};
                    Sacc[v2] = MF(KdA[ks], __builtin_bit_cast(bf16x8, vb), Sacc[v2]); }
            }
            if (FULL) {
                bf16x8 pa[2];
                {
                    f32x4 pT[4];
                    const LAS unsigned char* KT = (ti < 2) ? (lds + L_KT0) : (lds + L_KT1);
                    bf16x8 qf[4];
#pragma unroll
                    for (int ks = 0; ks < 4; ++ks) qf[ks] = *(const LAS bf16x8*)(lds + L_QT + (16 * ti + l15) * SQB + (8 * quad + 32 * ks) * 2);
#pragma unroll
                    for (int sj = 0; sj < 4; ++sj) {
                        bf16x8 kf[4];
#pragma unroll
                        for (int ks = 0; ks < 4; ++ks) kf[ks] = *(const LAS bf16x8*)(KT + (16 * sj + l15) * SQB + (8 * quad + 32 * ks) * 2);
                        pT[sj] = Z4;
#pragma unroll
                        for (int ks = 0; ks < 4; ++ks) pT[sj] = MF(kf[ks], qf[ks], pT[sj]);
                    }
#pragma unroll
                    for (int sj = 0; sj < 4; ++sj)
#pragma unroll
                        for (int j = 0; j < 4; ++j) { const bool keep = (sj < ti) || (sj == ti && 4 * quad + j <= l15); pT[sj][j] = keep ? pT[sj][j] : 0.f; }
#pragma unroll
                    for (int pp = 0; pp < 2; ++pp) { u32x4 x; x.x = cvt_pk_bf16(pT[2 * pp][0], pT[2 * pp][1]); x.y = cvt_pk_bf16(pT[2 * pp][2], pT[2 * pp][3]);
                        x.z = cvt_pk_bf16(pT[2 * pp + 1][0], pT[2 * pp + 1][1]); x.w = cvt_pk_bf16(pT[2 * pp + 1][2], pT[2 * pp + 1][3]); pa[pp] = __builtin_bit_cast(bf16x8, x); }
                }
#pragma unroll 2
                for (int i = 0; i < 4; ++i) { const int vt = 4 * vh + i;
                    f32x4 o = Z4;
#pragma unroll
                    for (int ks = 0; ks < 4; ++ks) { const bf16x8 qdf = *(const LAS bf16x8*)(lds + L_QD + (16 * ti + l15) * SQB + (8 * quad + 32 * ks) * 2);
                        const bf16x8 bfr = *(const LAS bf16x8*)(lds + L_ST + (16 * vt + l15) * SQB + (8 * quad + 32 * ks) * 2); o = MF(qdf, bfr, o); }
#pragma unroll
                    for (int pp = 0; pp < 2; ++pp) { const LAS unsigned char* vp = lds + vtb + (32 * pp + 4 * quad + (l15 >> 2)) * SVR + (16 * vt + 4 * (l15 & 3)) * 2;
                        const u32x2 v0 = TRR(vp), v1 = TRR(vp + 16 * SVR); const u32x4 vb = (u32x4){v0.x, v0.y, v1.x, v1.y};
                        o = MF(pa[pp], __builtin_bit_cast(bf16x8, vb), o); }
                    bf16_t* op = (bf16_t*)Ob + (rowbase + (size_t)c * CH + 16 * ti + 4 * quad) * D + colq + 16 * vt + l15;
                    const unsigned o01 = cvt_pk_bf16(o[0], o[1]), o23 = cvt_pk_bf16(o[2], o[3]);
                    op[0] = (bf16_t)(o01 & 0xffffu); op[(size_t)D] = (bf16_t)(o01 >> 16); op[(size_t)2 * D] = (bf16_t)(o23 & 0xffffu); op[(size_t)3 * D] = (bf16_t)(o23 >> 16);
                }
            }
            if (FULL) LBAR();
            if (FULL) {
#pragma unroll
                for (int v2 = 0; v2 < 8; ++v2) { u32x2 sw; sw.x = cvt_pk_bf16(Sacc[v2][0], Sacc[v2][1]); sw.y = cvt_pk_bf16(Sacc[v2][2], Sacc[v2][3]);
                    *(LAS u32x2*)(lds + L_ST + (16 * v2 + l15) * SQB + (16 * w + 4 * quad) * 2) = sw; }
            }
            S2_STORE(vtn, tln);
        }
        if (!FULL) {
            float* sl = SLOC + (size_t)(bh * NSEG + seg) * 128 * 128;
#pragma unroll
            for (int vt = 0; vt < 8; ++vt)
#pragma unroll
                for (int j = 0; j < 4; ++j) sl[(16 * w + 4 * quad + j) * 128 + 16 * vt + l15] = Sacc[vt][j];
            if (l15 == 0) { f32x4 pv;
#pragma unroll
                for (int j = 0; j < 4; ++j) pv[j] = __expf(sumal[j]);
                *(f32x4*)(PLOC + (size_t)(bh * NSEG + seg) * 128 + 16 * w + 4 * quad) = pv; }
        } else if (g == 0 && seg == NSEG - 1) {
#pragma unroll
            for (int vt = 0; vt < 8; ++vt)
#pragma unroll
                for (int j = 0; j < 4; ++j) sb[(16 * w + 4 * quad + j) * 128 + 16 * vt + l15] = Sacc[vt][j];
        }
        __syncthreads();
#undef S2_LOAD
#undef S2_STORE
#undef S2_LF
    }
}
#undef TCOL
#undef TRR
}


#define XB_TMO      128
#define XB_XCNT(j)  (256  + 64 * (j))
#define XB_XSUB(j)  (1280 + 64 * (j))
#define XB_XGEN(j)  (2304 + 64 * (j))
#define XB_TOP      3328
#define XB_TOPGEN   3392
#define XCD_BAR_WORDS 3456
#define XB_SPIN_CAP (1u << 22)
__device__ __forceinline__ unsigned xb_ld(unsigned* p)              { return __hip_atomic_load(p, __ATOMIC_RELAXED, __HIP_MEMORY_SCOPE_AGENT); }
__device__ __forceinline__ unsigned xb_add(unsigned* p, unsigned v) { return __hip_atomic_fetch_add(p, v, __ATOMIC_RELAXED, __HIP_MEMORY_SCOPE_AGENT); }
__device__ __forceinline__ unsigned xb_xcc_id() { return (unsigned)__builtin_amdgcn_s_getreg((3 << 11) | 20) & 0xFu; }
#define XB_SPIN(cond, bar) do { unsigned _sp = 0; while (cond) { __builtin_amdgcn_s_sleep(1); \
    if ((++_sp & 255u) == 0u) { if (xb_ld(&(bar)[XB_TMO])) break; if (_sp > XB_SPIN_CAP) { atomicAdd(&(bar)[XB_TMO], 1u); break; } } } } while (0)
struct XcdBarrier { unsigned* bar; unsigned x; volatile LAS unsigned* st; };
__device__ __forceinline__ XcdBarrier xcd_barrier_post(unsigned* bar, volatile LAS unsigned* st) {
    XcdBarrier b; b.bar = bar; b.x = xb_xcc_id(); b.st = st;
    if (threadIdx.x == 0) (void)xb_add(&bar[XB_XCNT(b.x)], 1u);
    return b;
}
__device__ __forceinline__ void xcd_barrier_complete(unsigned* bar, unsigned x, unsigned& nloc, unsigned& nx) {
    const unsigned G = gridDim.x * gridDim.y * gridDim.z;
    unsigned sum, cnt, mine, sp = 0u;
    for (;;) {
        sum = 0u; cnt = 0u; mine = 0u;
#pragma unroll
        for (unsigned j = 0; j < 16; ++j) { const unsigned c = xb_ld(&bar[XB_XCNT(j)]); sum += c; cnt += (c > 0u) ? 1u : 0u; mine = (j == x) ? c : mine; }
        if (sum == G) break;
        __builtin_amdgcn_s_sleep(1);
        if ((++sp & 255u) == 0u) { if (xb_ld(&bar[XB_TMO])) break; if (sp > XB_SPIN_CAP) { atomicAdd(&bar[XB_TMO], 1u); break; } }
    }
    nloc = mine > 0u ? mine : 1u; nx = cnt > 0u ? cnt : 1u;
}
__device__ __forceinline__ void xcd_barrier(const XcdBarrier& b) {
    asm volatile("s_waitcnt vmcnt(0)" ::: "memory");
    __syncthreads();
    if (threadIdx.x == 0) {
        unsigned* bar = b.bar;
        __builtin_amdgcn_s_waitcnt(0);
        unsigned nloc = b.st[0], nx = b.st[1];
        if (nloc == 0u) { xcd_barrier_complete(bar, b.x, nloc, nx); b.st[0] = nloc; b.st[1] = nx; }
        const unsigned old = xb_add(&bar[XB_XSUB(b.x)], 1u);
        const unsigned gen = old / nloc;
        if (old + 1u == (gen + 1u) * nloc) {
            __builtin_amdgcn_fence(__ATOMIC_RELEASE, "agent");
            asm volatile("s_waitcnt vmcnt(0)" ::: "memory");
            const unsigned og = xb_add(&bar[XB_TOP], 1u);
            const unsigned tg = og / nx;
            if (og + 1u == (tg + 1u) * nx) xb_add(&bar[XB_TOPGEN], 1u);
            else XB_SPIN(xb_ld(&bar[XB_TOPGEN]) == tg, bar);
            __builtin_amdgcn_fence(__ATOMIC_ACQUIRE, "agent");
            xb_add(&bar[XB_XGEN(b.x)], 1u);
            asm volatile("s_waitcnt vmcnt(0)" ::: "memory");
        } else {
            XB_SPIN(xb_ld(&bar[XB_XGEN(b.x)]) == gen, bar);
            __builtin_amdgcn_fence(__ATOMIC_ACQUIRE, "agent");
            asm volatile("s_waitcnt vmcnt(0)" ::: "memory");
        }
    }
    __syncthreads();
}

__global__ void __launch_bounds__(NTHREADS, 2) fwd_megakernel(Args a) {
    extern __shared__ __attribute__((aligned(16))) unsigned char lds_raw[];
    LAS unsigned char* lds = (LAS unsigned char*)lds_raw;
    cg::grid_group grid = cg::this_grid();
    if (threadIdx.x < 16) ((LAS unsigned*)(lds + MISC_OFF))[threadIdx.x] = 0u;
    __syncthreads();
    const XcdBarrier xbar = xcd_barrier_post((unsigned*)(a.ws + WS_CTL), (volatile LAS unsigned*)(lds + MISC_OFF));
    grid.sync();
    for (int i = 0; i < 17; ++i) a.in[i] = as_global(a.in[i]);
    a.out = as_global(a.out); a.ws = as_global(a.ws);
    const float* ng = a.in[I_NG];
    float* out = a.out;
#define GSYNC() xcd_barrier(xbar)
#define WSP(off) (cx.ws + (off))
#define ADA ((const float*)WSP(WS_ADA))

    { const Ctx cx = mkctx(a.ws); p0_prologue(a, lds, cx); }
    GSYNC();
    { const Ctx cx = mkctx(a.ws); normmod_phase(a.in[I_X], ng + 0 * D, ADA, 0, 1, (bf16_t*)WSP(WS_H1), cx); }
    GSYNC();
    { const Ctx cx = mkctx(a.ws); pg8::Gemm g{(const bf16_t*)WSP(WS_H1), (const bf16_t*)WSP(WS_W1IN), M, 2 * FF, D}; pg8::StaticOrder S; S.init(M, 2 * FF, cx.G, cx.bid);
      pg8::EpiSwiGLU E{(bf16_t*)WSP(WS_ACT1), FF}; pg8::gemm_phase(lds, g, S, E, cx.tid); }
    GSYNC();
    { const Ctx cx = mkctx(a.ws); pg8::Gemm g{(const bf16_t*)WSP(WS_ACT1), (const bf16_t*)WSP(WS_W1OUT), M, D, FF}; pg8::StaticOrder S; S.init(M, D, cx.G, cx.bid);
      pg8::EpiStore E{(bf16_t*)WSP(WS_Y1), D}; pg8::gemm_phase(lds, g, S, E, cx.tid); }
    GSYNC();
    { const Ctx cx = mkctx(a.ws); res_phase<true, false, true, false, true>((const bf16_t*)WSP(WS_Y1), a.in[I_X], WSP(WS_XB), 0.5f, ADA, 2, ng + 1 * D, ng + 2 * D, 3, 4, (bf16_t*)WSP(WS_H2), cx); }
    GSYNC();
    for (int g = 0; g < NG; ++g) {
        { const Ctx cx = mkctx(a.ws); bf16_t* H2g = (bf16_t*)WSP(WS_H2) + (size_t)g * MG * D;
          pg8::Gemm gm{H2g, (const bf16_t*)WSP(WS_WMIX), MG, NMIX, D}; pg8::StaticOrder S; S.init(MG, NMIX, cx.G, cx.bid);
          pg8::EpiMix E{(bf16_t*)WSP(WS_CB), (bf16_t*)WSP(WS_P), (bf16_t*)WSP(WS_Q), (bf16_t*)WSP(WS_LF), (bf16_t*)WSP(WS_V), (bf16_t*)WSP(WS_GS), (bf16_t*)WSP(WS_SA), (bf16_t*)WSP(WS_SB),
                        (const float*)WSP(WS_LB), (bf16_t*)WSP(WS_KK)};
          pg8::gemm_phase(lds, gm, S, E, cx.tid); }
        GSYNC();
        { const Ctx cx = mkctx(a.ws); conv_phase((bf16_t*)WSP(WS_CB), (const bf16_t*)WSP(WS_P), (bf16_t*)WSP(WS_HALO), a.in[I_CONVW], a.in[I_CONVB], g, cx); }
        { const Ctx cx = mkctx(a.ws); float* sloc = (float*)((bf16_t*)WSP(WS_H2) + (size_t)g * MG * D);
          scan2::scan_pass<false>(lds, (const bf16_t*)WSP(WS_Q), (const bf16_t*)WSP(WS_LF), (const bf16_t*)WSP(WS_KK), (const bf16_t*)WSP(WS_V), (float*)WSP(WS_O), (float*)WSP(WS_SBUF), sloc, (float*)WSP(WS_PLOC), g, cx); }
        GSYNC();
        { const Ctx cx = mkctx(a.ws); float* sloc = (float*)((bf16_t*)WSP(WS_H2) + (size_t)g * MG * D);
          scan2::scan_pass<true>(lds, (const bf16_t*)WSP(WS_Q), (const bf16_t*)WSP(WS_LF), (const bf16_t*)WSP(WS_KK), (const bf16_t*)WSP(WS_V), (float*)WSP(WS_O), (float*)WSP(WS_SBUF), sloc, (float*)WSP(WS_PLOC), g, cx); }
        GSYNC();
        { const Ctx cx = mkctx(a.ws); og_phase((const float*)WSP(WS_O), (const bf16_t*)WSP(WS_GS), a.in[I_HGG], (bf16_t*)WSP(WS_Q), cx); }
        GSYNC();
        { const Ctx cx = mkctx(a.ws); pg8::Gemm gm{(const bf16_t*)WSP(WS_CB), (const bf16_t*)WSP(WS_WCO), MG, D, D}; pg8::StaticOrder S; S.init(MG, D, cx.G, cx.bid);
          pg8::EpiGate<0> E{(bf16_t*)WSP(WS_SA), (const bf16_t*)WSP(WS_SB)}; pg8::gemm_phase(lds, gm, S, E, cx.tid); }
        { const Ctx cx = mkctx(a.ws); pg8::Gemm gm{(const bf16_t*)WSP(WS_Q), (const bf16_t*)WSP(WS_WHO), MG, D, D}; pg8::StaticOrder S; S.init(MG, D, cx.G, cx.bid);
          pg8::EpiGate<1> E{(bf16_t*)WSP(WS_SA), (const bf16_t*)WSP(WS_SB)}; pg8::gemm_phase(lds, gm, S, E, cx.tid); }
        GSYNC();
        { const Ctx cx = mkctx(a.ws); bf16_t* H2g = (bf16_t*)WSP(WS_H2) + (size_t)g * MG * D;
          pg8::Gemm gm{(const bf16_t*)WSP(WS_SA), (const bf16_t*)WSP(WS_WMO), MG, D, D}; pg8::StaticOrder S; S.init(MG, D, cx.G, cx.bid);
          pg8::EpiStore E{H2g, D}; pg8::gemm_phase(lds, gm, S, E, cx.tid); }
        GSYNC();
    }
    { const Ctx cx = mkctx(a.ws); res_phase<true, true, false, true, true>((const bf16_t*)WSP(WS_H2), WSP(WS_XB), WSP(WS_XB), 1.0f, ADA, 5, ng + 3 * D, ng + 4 * D, 6, 7, (bf16_t*)WSP(WS_H3), cx); }
    GSYNC();
    { const Ctx cx = mkctx(a.ws); pg8::Gemm g{(const bf16_t*)WSP(WS_H3), (const bf16_t*)WSP(WS_W2IN), M, 2 * FF, D}; pg8::StaticOrder S; S.init(M, 2 * FF, cx.G, cx.bid);
      pg8::EpiSwiGLU E{(bf16_t*)WSP(WS_ACT2), FF}; pg8::gemm_phase(lds, g, S, E, cx.tid); }
    GSYNC();
    { const Ctx cx = mkctx(a.ws); pg8::Gemm g{(const bf16_t*)WSP(WS_ACT2), (const bf16_t*)WSP(WS_W2OUT), M, D, FF}; pg8::StaticOrder S; S.init(M, D, cx.G, cx.bid);
      pg8::EpiStore E{(bf16_t*)WSP(WS_Y2), D}; pg8::gemm_phase(lds, g, S, E, cx.tid); }
    GSYNC();
    { const Ctx cx = mkctx(a.ws); res_phase<false, false, false, true, false>((const bf16_t*)WSP(WS_Y2), WSP(WS_XB), out, 0.5f, ADA, 8, ng + 5 * D, nullptr, 0, 0, nullptr, cx); }
#undef GSYNC
}

extern "C" void kernel_launch(void* const* d_in, const int* in_sizes, int n_in, void* d_out, int out_size, void* d_ws, size_t ws_size, hipStream_t stream) {
    static int grid = 0;
    if (grid == 0) {
        if (n_in != 17 || in_sizes[0] != M * D || out_size != M * D || ws_size < WS_END) {
            fprintf(stderr, "kernel_launch: unexpected shapes (n_in %d, in0 %d, out %d, ws %zu)\n", n_in, n_in > 0 ? in_sizes[0] : -1, out_size, ws_size); grid = -1; return; }
        int dev = 0, cus = 0, per_cu = 0;
        if (hipGetDevice(&dev) != hipSuccess || hipDeviceGetAttribute(&cus, hipDeviceAttributeMultiprocessorCount, dev) != hipSuccess) { grid = -1; return; }
        if (hipFuncSetAttribute((const void*)fwd_megakernel, hipFuncAttributeMaxDynamicSharedMemorySize, LDS_BYTES) != hipSuccess) { fprintf(stderr, "kernel_launch: hipFuncSetAttribute failed\n"); grid = -1; return; }
        if (hipOccupancyMaxActiveBlocksPerMultiprocessor(&per_cu, (const void*)fwd_megakernel, NTHREADS, LDS_BYTES) != hipSuccess || per_cu < 1) { fprintf(stderr, "kernel_launch: occupancy query says %d\n", per_cu); per_cu = 1; }
        (void)hipGetLastError();
        grid = cus * 1;
        if (grid > 256) grid = 256;
    }
    if (grid < 0) return;
    if (hipMemsetAsync((char*)d_ws + WS_CTL, 0, CTL_BYTES, stream) != hipSuccess) { fprintf(stderr, "kernel_launch: memset failed\n"); return; }
    Args a{};
    for (int i = 0; i < 17; ++i) a.in[i] = (const float*)d_in[i];
    a.out = (float*)d_out; a.ws = (unsigned char*)d_ws;
    void* args[] = {&a};
    hipError_t e = hipLaunchCooperativeKernel((const void*)fwd_megakernel, dim3(grid), dim3(NTHREADS), args, LDS_BYTES, stream);
    if (e != hipSuccess) fprintf(stderr, "kernel_launch: cooperative launch failed: %s (grid %d)\n", hipGetErrorString(e), grid);
}
```

```cpp
#include <hip/hip_runtime.h>
#include <hip/hip_cooperative_groups.h>
#include <cstdio>
#include <cstdint>
namespace cg = cooperative_groups;

#define LAS __attribute__((address_space(3)))
#define GAS __attribute__((address_space(1)))
template <class T> __device__ __forceinline__ T* as_global(T* p) { unsigned long long u = (unsigned long long)p; asm volatile("" : "+s"(u)); return (T*)(GAS T*)u; }
typedef unsigned short bf16_t;
typedef short bf16x8 __attribute__((ext_vector_type(8)));
typedef short s16x4 __attribute__((ext_vector_type(4)));
typedef float f32x4 __attribute__((ext_vector_type(4)));
typedef float f32x2 __attribute__((ext_vector_type(2)));
typedef unsigned u32x4 __attribute__((ext_vector_type(4)));
typedef unsigned u32x2 __attribute__((ext_vector_type(2)));

constexpr int D = 1024, NB = 8, SEQ = 8192, M = NB * SEQ, FF = 2816, NMIX = 9216;
constexpr int NG = 2, SG = SEQ / NG, MG = NB * SG, CH = 64, NCH = SG / CH;
constexpr float EPS = 1e-6f;
constexpr int NTHREADS = 512, NWAVES = 8;

constexpr size_t MiB = 1u << 20;
constexpr size_t WS_ADA = 0;
constexpr size_t WS_LB = 320 * 1024;
constexpr size_t WS_HALO = 384 * 1024;
constexpr size_t WS_PLOC = 512 * 1024;
constexpr size_t WS_SBUF = 1 * MiB;
constexpr size_t WS_CTL = 5 * MiB, CTL_BYTES = 65536;
constexpr size_t WS_W1IN = 6 * MiB, WS_W1OUT = 17 * MiB, WS_WMIX = 23 * MiB, WS_WCO = 41 * MiB, WS_WHO = 43 * MiB, WS_WMO = 45 * MiB, WS_W2IN = 47 * MiB, WS_W2OUT = 58 * MiB;
constexpr size_t WS_H1 = 64 * MiB, WS_ACT1 = 192 * MiB, WS_Y1 = 544 * MiB;
constexpr size_t WS_H2 = 64 * MiB;
constexpr size_t WS_CB = 192 * MiB, WS_P = 256 * MiB, WS_Q = 320 * MiB, WS_LF = 384 * MiB, WS_V = 448 * MiB, WS_GS = 512 * MiB, WS_SA = 576 * MiB, WS_SB = 640 * MiB, WS_O = 704 * MiB, WS_KK = 832 * MiB;
constexpr size_t WS_XB = 896 * MiB;
constexpr size_t WS_H3 = 192 * MiB, WS_ACT2 = 320 * MiB, WS_Y2 = 672 * MiB;
constexpr size_t WS_END = 1024 * MiB;

constexpr int LDS_BYTES = 158 * 1024;
constexpr int MISC_OFF = LDS_BYTES - 64;

__device__ __forceinline__ float bf2f(unsigned b) { return __uint_as_float(b << 16); }
__device__ __forceinline__ float bflo(unsigned w) { return __uint_as_float(w << 16); }
__device__ __forceinline__ float bfhi(unsigned w) { return __uint_as_float(w & 0xffff0000u); }
typedef __bf16 bf16v2 __attribute__((ext_vector_type(2)));
__device__ __forceinline__ unsigned cvt_pk_bf16(float lo, float hi) { const f32x2 v = {lo, hi}; const bf16v2 r = __builtin_convertvector(v, bf16v2); return __builtin_bit_cast(unsigned, r); }
__device__ __forceinline__ float fsigmoid(float x) { return __builtin_amdgcn_rcpf(1.0f + __expf(-x)); }
__device__ __forceinline__ float fsilu(float x) { return x * fsigmoid(x); }
__device__ __forceinline__ float wave_sum(float v) {
#pragma unroll
    for (int o = 1; o < 64; o <<= 1) v += __shfl_xor(v, o);
    return v;
}

namespace pg8 {
constexpr int BM = 256, BK = 64, HALF = 128, HTB = HALF * BK * 2, STAGE_BYTES = 8 * HTB, NXCD = 8, WGM = 16;
__host__ __device__ __forceinline__ int lds_byte(int r, int c) { const int st = (r >> 4) * 2 + (c >> 5), rr = r & 15, cc = c & 31, ob = rr * 64 + cc * 2; return st * 1024 + (ob ^ (((ob >> 9) & 1) << 5)); }
__host__ __device__ __forceinline__ void stage_rc(int b, int& R, int& C) { const int st = b / 1024, sb = b % 1024, swz = sb ^ (((sb >> 9) & 1) << 5); R = (st >> 1) * 16 + swz / 64; C = (st & 1) * 32 + (swz % 64) / 2; }
__host__ __device__ __forceinline__ int perm32(int rho) { const int n = rho >> 4, i = rho & 15; return 8 * (i >> 2) + 4 * n + (i & 3); }

struct Unit { int pm, pn; };
struct Gemm { const bf16_t* A; const bf16_t* Bt; int M, N, K; };

struct StaticOrder {
    int nM, nN, nwg, G, c;
    __host__ __device__ void init(int M_, int N_, int G_, int c_) { nM = M_ / BM; nN = N_ / BM; nwg = nM * nN; G = G_; c = c_; }
    __host__ __device__ bool next(int i, Unit& u) const {
        const long L = (long)i * G + c; if (L >= nwg) return false;
        int wgid = (int)L; { const int q = nwg / NXCD, r = nwg % NXCD, xcd = wgid % NXCD, off = wgid / NXCD; wgid = (xcd < r ? xcd * (q + 1) : r * (q + 1) + (xcd - r) * q) + off; }
        const int nig = WGM * nN, gid = wgid / nig, fm = gid * WGM, gsz = (nM - fm) < WGM ? (nM - fm) : WGM;
        u.pm = fm + ((wgid % nig) % gsz); u.pn = (wgid % nig) / gsz; return true;
    }
};

template <class Epi>
__device__ __forceinline__ void gemm_phase(LAS unsigned char* lds, const Gemm g, const StaticOrder& S, const Epi& E, const int tid) {
    const int wid = __builtin_amdgcn_readfirstlane(tid >> 6), lane = tid & 63, wr = wid >> 2, wc = wid & 3, fr = lane & 15, fq = lane >> 4;
    const int K = g.K, nt = K / BK;
    unsigned voffA[2], voffB[2];
#pragma unroll
    for (int i = 0; i < 2; ++i) { int R, C; stage_rc(tid * 16 + i * 8192, R, C); const int Rb = ((R & ~31) + perm32(R & 31));
        voffA[i] = (unsigned)(R * K + C) * 2u; voffB[i] = (unsigned)(Rb * K + C) * 2u; }
    const size_t kstep = (size_t)(BK * 2);
    const size_t hstep = (size_t)HALF * K * 2;
    const size_t tstep = 2 * hstep;
    const unsigned ldsw = (unsigned)wid * 1024u;
    const int aoff = lds_byte(wr * 64 + fr, fq * 8), boff = lds_byte(wc * 32 + fr, fq * 8);
#define PG8_SA(b, h) (((b) * 2 + (h)) * HTB)
#define PG8_SB(b, h) ((4 + (b) * 2 + (h)) * HTB)
#define PG8_STAGE(bufoff, gbase, voff) do { _Pragma("unroll") for (int _i = 0; _i < 2; ++_i) \
        __builtin_amdgcn_global_load_lds((const unsigned*)((const char*)(gbase) + (voff)[_i]), (LAS unsigned*)(lds + (bufoff) + ldsw + _i * 8192), 16, 0, 0); } while (0)
#define PG8_LDA(dst, b, h) do { _Pragma("unroll") for (int m = 0; m < 4; ++m) _Pragma("unroll") for (int k = 0; k < 2; ++k) dst[m][k] = *(const LAS bf16x8*)(lds + PG8_SA(b, h) + aoff + m * 2048 + k * 1024); } while (0)
#define PG8_LDB(dst, b, h) do { _Pragma("unroll") for (int n = 0; n < 2; ++n) _Pragma("unroll") for (int k = 0; k < 2; ++k) dst[n][k] = *(const LAS bf16x8*)(lds + PG8_SB(b, h) + boff + n * 2048 + k * 1024); } while (0)
#define PG8_MMA(ai, bj, At, Bt) do { __builtin_amdgcn_s_setprio(1); _Pragma("unroll") for (int m = 0; m < 4; ++m) _Pragma("unroll") for (int n = 0; n < 2; ++n) _Pragma("unroll") for (int k = 0; k < 2; ++k) \
        acc[ai][bj][m][n] = __builtin_amdgcn_mfma_f32_16x16x32_bf16(Bt[n][k], At[m][k], acc[ai][bj][m][n], 0, 0, 0); __builtin_amdgcn_s_setprio(0); } while (0)
#define PG8_WAIT_V(n) asm volatile("s_waitcnt vmcnt(" #n ")" ::: "memory")
#define PG8_WAIT_L(n) asm volatile("s_waitcnt lgkmcnt(" #n ")" ::: "memory")
#define PG8_BAR __builtin_amdgcn_s_barrier()
#define PG8_SCHED __builtin_amdgcn_sched_barrier(0)
    Unit cur, nxt; int ui = 0;
    if (!S.next(0, cur)) return;
    f32x4 acc[2][2][4][2];
#pragma unroll
    for (int a = 0; a < 2; ++a)
#pragma unroll
        for (int b = 0; b < 2; ++b)
#pragma unroll
            for (int m = 0; m < 4; ++m)
#pragma unroll
                for (int n = 0; n < 2; ++n) acc[a][b][m][n] = (f32x4){0.f, 0.f, 0.f, 0.f};
    bf16x8 At[4][2], B0[2][2], B1[2][2];
    const char* cA = (const char*)g.A + (size_t)cur.pm * tstep; const char* cB = (const char*)g.Bt + (size_t)cur.pn * tstep;
    PG8_STAGE(PG8_SB(0, 0), cB, voffB); PG8_STAGE(PG8_SB(0, 1), cB + hstep, voffB); PG8_STAGE(PG8_SA(0, 0), cA, voffA); PG8_STAGE(PG8_SA(0, 1), cA + hstep, voffA);
    if (wr == 1) PG8_BAR;
    PG8_WAIT_V(2); PG8_BAR;
    PG8_STAGE(PG8_SB(1, 0), cB + kstep, voffB); PG8_STAGE(PG8_SA(1, 0), cA + kstep, voffA); PG8_STAGE(PG8_SB(1, 1), cB + hstep + kstep, voffB);
    PG8_WAIT_V(6); PG8_BAR;
    for (;;) {
        const bool has_next = S.next(ui + 1, nxt);
        const char* nA = has_next ? (const char*)g.A + (size_t)nxt.pm * tstep : cA; const char* nB = has_next ? (const char*)g.Bt + (size_t)nxt.pn * tstep : cB;
        for (int t = 0; t < nt; t += 2) {
            const bool last = (t == nt - 2);
            const char* a1 = cA + (size_t)(t + 1) * kstep;
            const char* a2 = last ? nA : cA + (size_t)(t + 2) * kstep; const char* b2 = last ? nB : cB + (size_t)(t + 2) * kstep;
            const char* a3 = a2 + kstep; const char* b3 = b2 + kstep;
            PG8_LDB(B0, 0, 0); PG8_LDB(B1, 0, 1); PG8_SCHED; PG8_LDA(At, 0, 0); PG8_STAGE(PG8_SA(1, 1), a1 + hstep, voffA);
            PG8_WAIT_V(8); PG8_WAIT_L(0); PG8_BAR; PG8_MMA(0, 0, At, B0); PG8_MMA(0, 1, At, B1); PG8_BAR; PG8_SCHED;
            PG8_LDA(At, 0, 1); PG8_STAGE(PG8_SB(0, 0), b2, voffB); PG8_STAGE(PG8_SB(0, 1), b2 + hstep, voffB); PG8_STAGE(PG8_SA(0, 0), a2, voffA);
            PG8_WAIT_V(8); PG8_WAIT_L(0); PG8_BAR; PG8_MMA(1, 0, At, B0); PG8_MMA(1, 1, At, B1); PG8_BAR; PG8_SCHED;
            PG8_LDB(B0, 1, 0); PG8_LDB(B1, 1, 1); PG8_SCHED; PG8_LDA(At, 1, 0); PG8_STAGE(PG8_SA(0, 1), a2 + hstep, voffA);
            PG8_WAIT_V(8); PG8_WAIT_L(0); PG8_BAR; PG8_MMA(0, 0, At, B0); PG8_MMA(0, 1, At, B1); PG8_BAR; PG8_SCHED;
            PG8_LDA(At, 1, 1); PG8_STAGE(PG8_SB(1, 0), b3, voffB); PG8_STAGE(PG8_SB(1, 1), b3 + hstep, voffB); PG8_STAGE(PG8_SA(1, 0), a3, voffA);
            PG8_WAIT_V(8); PG8_WAIT_L(0); PG8_BAR; PG8_MMA(1, 0, At, B0); PG8_MMA(1, 1, At, B1); PG8_BAR; PG8_SCHED;
        }
        if (wr == 0) PG8_BAR;
        E(acc, cur, wr, wc, fr, fq);
        if (!has_next) break;
#pragma unroll
        for (int a = 0; a < 2; ++a)
#pragma unroll
            for (int b = 0; b < 2; ++b)
#pragma unroll
                for (int m = 0; m < 4; ++m)
#pragma unroll
                    for (int n = 0; n < 2; ++n) acc[a][b][m][n] = (f32x4){0.f, 0.f, 0.f, 0.f};
        cur = nxt; cA = nA; cB = nB; ++ui;
        if (wr == 1) PG8_BAR;
    }
    PG8_WAIT_V(0);
    PG8_BAR;
#undef PG8_SA
#undef PG8_SB
#undef PG8_STAGE
#undef PG8_LDA
#undef PG8_LDB
#undef PG8_MMA
#undef PG8_WAIT_V
#undef PG8_WAIT_L
#undef PG8_BAR
#undef PG8_SCHED
}

typedef f32x4 AccT[2][2][4][2];

struct EpiStore {
    bf16_t* O; int ldc;
    __device__ __forceinline__ void operator()(const AccT& acc, const Unit& u, int wr, int wc, int fr, int fq) const {
        const int row0 = u.pm * BM + wr * 64 + fr, col0 = u.pn * BM + wc * 32 + 8 * fq;
#pragma unroll
        for (int ai = 0; ai < 2; ++ai)
#pragma unroll
            for (int m = 0; m < 4; ++m) { bf16_t* rowp = O + (size_t)(row0 + ai * HALF + m * 16) * ldc + col0;
#pragma unroll
                for (int bj = 0; bj < 2; ++bj) { const f32x4 v0 = acc[ai][bj][m][0], v1 = acc[ai][bj][m][1];
                    u32x4 w; w.x = cvt_pk_bf16(v0[0], v0[1]); w.y = cvt_pk_bf16(v0[2], v0[3]); w.z = cvt_pk_bf16(v1[0], v1[1]); w.w = cvt_pk_bf16(v1[2], v1[3]);
                    __builtin_nontemporal_store(w, (u32x4*)(rowp + bj * HALF)); } }
    }
};
struct EpiSwiGLU {
    bf16_t* O; int ldc;
    __device__ __forceinline__ void operator()(const AccT& acc, const Unit& u, int wr, int wc, int fr, int fq) const {
        const int row0 = u.pm * BM + wr * 64 + fr, col0 = u.pn * HALF + wc * 32 + 8 * fq;
#pragma unroll
        for (int ai = 0; ai < 2; ++ai)
#pragma unroll
            for (int m = 0; m < 4; ++m) { bf16_t* rowp = O + (size_t)(row0 + ai * HALF + m * 16) * ldc + col0;
                float r[8];
#pragma unroll
                for (int n = 0; n < 2; ++n)
#pragma unroll
                    for (int j = 0; j < 4; ++j) { const float a = acc[ai][0][m][n][j], b = acc[ai][1][m][n][j]; r[n * 4 + j] = fsilu(a) * b; }
                u32x4 w; w.x = cvt_pk_bf16(r[0], r[1]); w.y = cvt_pk_bf16(r[2], r[3]); w.z = cvt_pk_bf16(r[4], r[5]); w.w = cvt_pk_bf16(r[6], r[7]);
                __builtin_nontemporal_store(w, (u32x4*)rowp); }
    }
};
template <int MODE> struct EpiGate {
    bf16_t* SA; const bf16_t* SB;
    __device__ __forceinline__ void operator()(const AccT& acc, const Unit& u, int wr, int wc, int fr, int fq) const {
        const int row0 = u.pm * BM + wr * 64 + fr, col0 = u.pn * BM + wc * 32 + 8 * fq;
#pragma unroll
        for (int ai = 0; ai < 2; ++ai)
#pragma unroll
            for (int m = 0; m < 4; ++m) { const size_t off = (size_t)(row0 + ai * HALF + m * 16) * D + col0;
#pragma unroll
                for (int bj = 0; bj < 2; ++bj) { const f32x4 v0 = acc[ai][bj][m][0], v1 = acc[ai][bj][m][1];
                    const u32x4 s = *(const u32x4*)(SA + off + bj * HALF);
                    float r[8];
                    if (MODE == 0) {
                        r[0] = bflo(s.x) * v0[0]; r[1] = bfhi(s.x) * v0[1]; r[2] = bflo(s.y) * v0[2]; r[3] = bfhi(s.y) * v0[3];
                        r[4] = bflo(s.z) * v1[0]; r[5] = bfhi(s.z) * v1[1]; r[6] = bflo(s.w) * v1[2]; r[7] = bfhi(s.w) * v1[3];
                    } else {
                        const u32x4 t = *(const u32x4*)(SB + off + bj * HALF);
                        r[0] = bflo(s.x) + bflo(t.x) * v0[0]; r[1] = bfhi(s.x) + bfhi(t.x) * v0[1]; r[2] = bflo(s.y) + bflo(t.y) * v0[2]; r[3] = bfhi(s.y) + bfhi(t.y) * v0[3];
                        r[4] = bflo(s.z) + bflo(t.z) * v1[0]; r[5] = bfhi(s.z) + bfhi(t.z) * v1[1]; r[6] = bflo(s.w) + bflo(t.w) * v1[2]; r[7] = bfhi(s.w) + bfhi(t.w) * v1[3];
                    }
                    u32x4 w; w.x = cvt_pk_bf16(r[0], r[1]); w.y = cvt_pk_bf16(r[2], r[3]); w.z = cvt_pk_bf16(r[4], r[5]); w.w = cvt_pk_bf16(r[6], r[7]);
                    *(u32x4*)(SA + off + bj * HALF) = w; } }
    }
};
struct EpiMix {
    bf16_t *CB, *P, *Q, *LF, *V, *GS, *SA, *SB; const float* lb; bf16_t* KK;
    template <int TYPE>
    __device__ __forceinline__ void tile(bf16_t* O, const AccT& acc, int row0, int colbase) const {
#pragma unroll
        for (int bj = 0; bj < 2; ++bj) { const int col = colbase + bj * HALF;
            float lbv[8];
            if (TYPE == 3) { const f32x4 l0 = *(const f32x4*)(lb + col), l1 = *(const f32x4*)(lb + col + 4);
#pragma unroll
                for (int j = 0; j < 4; ++j) { lbv[j] = l0[j]; lbv[4 + j] = l1[j]; } }
#pragma unroll
            for (int ai = 0; ai < 2; ++ai)
#pragma unroll
                for (int m = 0; m < 4; ++m) { float r[8];
#pragma unroll
                    for (int n = 0; n < 2; ++n)
#pragma unroll
                        for (int j = 0; j < 4; ++j) { const float x = acc[ai][bj][m][n][j]; float y;
                            if (TYPE == 0) y = x; else if (TYPE == 1) y = fsilu(x); else if (TYPE == 2) y = fsigmoid(x);
                            else { const float l = lbv[n * 4 + j], sg = fsigmoid(x); y = __logf(l + (1.0f - l) * sg); }
                            r[n * 4 + j] = y; }
                    u32x4 w; w.x = cvt_pk_bf16(r[0], r[1]); w.y = cvt_pk_bf16(r[2], r[3]); w.z = cvt_pk_bf16(r[4], r[5]); w.w = cvt_pk_bf16(r[6], r[7]);
                    __builtin_nontemporal_store(w, (u32x4*)(O + (size_t)(row0 + ai * HALF + m * 16) * D + col)); } }
    }
    __device__ __forceinline__ void operator()(const AccT& acc, const Unit& u, int wr, int wc, int fr, int fq) const {
        const int row0 = u.pm * BM + wr * 64 + fr, pn = u.pn;
        if (pn >= 4 && pn < 12) {
            const int col0 = (pn - 4) * HALF + wc * 32 + 8 * fq;
#pragma unroll
            for (int ai = 0; ai < 2; ++ai)
#pragma unroll
                for (int m = 0; m < 4; ++m) { float r[8];
#pragma unroll
                    for (int n = 0; n < 2; ++n)
#pragma unroll
                        for (int j = 0; j < 4; ++j) r[n * 4 + j] = acc[ai][0][m][n][j] * acc[ai][1][m][n][j];
                    u32x4 w; w.x = cvt_pk_bf16(r[0], r[1]); w.y = cvt_pk_bf16(r[2], r[3]); w.z = cvt_pk_bf16(r[4], r[5]); w.w = cvt_pk_bf16(r[6], r[7]);
                    __builtin_nontemporal_store(w, (u32x4*)(P + (size_t)(row0 + ai * HALF + m * 16) * D + col0)); }
            return;
        }
        const int colbase = (pn & 3) * BM + wc * 32 + 8 * fq;
        if (pn < 4) tile<0>(CB, acc, row0, colbase);
        else if (pn < 16) tile<1>(Q, acc, row0, colbase);
        else if (pn < 20) tile<3>(LF, acc, row0, colbase);
        else if (pn < 24) tile<0>(V, acc, row0, colbase);
        else if (pn < 28) tile<1>(GS, acc, row0, colbase);
        else if (pn < 32) tile<2>(SA, acc, row0, colbase);
        else tile<2>(SB, acc, row0, colbase);
    }
};
}

struct Args { const float* in[17]; float* out; unsigned char* ws; };
enum { I_X = 0, I_C, I_WADA, I_BADA, I_NG, I_W1IN, I_W1OUT, I_WMIX, I_CONVW, I_CONVB, I_WCO, I_HGG, I_LBL, I_WHO, I_WMO, I_W2IN, I_W2OUT };

struct Ctx { int tid, lane, wave, G, bid; unsigned char* ws; };
__device__ __forceinline__ Ctx mkctx(unsigned char* ws_in) {
    Ctx c; int t = threadIdx.x; asm volatile("" : "+v"(t)); c.tid = t; c.lane = t & 63; c.wave = __builtin_amdgcn_readfirstlane(t >> 6);
    int g = gridDim.x; asm volatile("" : "+s"(g)); c.G = g; int b = blockIdx.x; asm volatile("" : "+s"(b)); c.bid = b;
    unsigned char* w = ws_in; asm volatile("" : "+s"(w)); c.ws = as_global(w); return c;
}

__device__ __forceinline__ int map_row(int mode, int n0) {
    if (mode == 1) { const int half = n0 >= FF ? 1 : 0; const int j = n0 - half * FF; return (j >> 7) * 256 + half * 128 + (j & 127); }
    if (mode == 2) { const int s = n0 >> 10, j = n0 & 1023; if (s == 1 || s == 2) return (4 + (j >> 7)) * 256 + (s - 1) * 128 + (j & 127); return n0; }
    return n0;
}
__device__ __forceinline__ void p0_transpose_item(const float* W, int K, int N, bf16_t* WT, int mode, LAS float* scr, int item, int lane) {
    const int nblk = N / 32, kb = item / nblk, nb = item % nblk, k0 = 64 * kb, n0 = 32 * nb;
    const int drow = map_row(mode, n0);
    float wv[32];
#pragma unroll
    for (int i = 0; i < 32; ++i) wv[i] = W[(size_t)(k0 + 2 * i + (lane >> 5)) * N + n0 + (lane & 31)];
#pragma unroll
    for (int i = 0; i < 32; ++i) scr[(2 * i + (lane >> 5)) * 33 + (lane & 31)] = wv[i];
    asm volatile("s_waitcnt lgkmcnt(0)" ::: "memory");
    const int c = lane & 7;
#pragma unroll
    for (int j = 0; j < 4; ++j) { const int n = (lane >> 3) + 8 * j; const LAS float* s = scr + (8 * c) * 33 + n;
        u32x4 o; o.x = cvt_pk_bf16(s[0 * 33], s[1 * 33]); o.y = cvt_pk_bf16(s[2 * 33], s[3 * 33]); o.z = cvt_pk_bf16(s[4 * 33], s[5 * 33]); o.w = cvt_pk_bf16(s[6 * 33], s[7 * 33]);
        *(u32x4*)(WT + (size_t)(drow + n) * K + k0 + 8 * c) = o; }
    asm volatile("s_waitcnt lgkmcnt(0)" ::: "memory");
}

__device__ __forceinline__ void p0_prologue(const Args& a, LAS unsigned char* lds, const Ctx& cx) {
    unsigned char* ws = cx.ws;
    const int G = cx.G, tid = cx.tid, wave = cx.wave, lane = cx.lane, bid = cx.bid;
    {
        LAS float* sc = (LAS float*)lds;
        LAS float* red = (LAS float*)(lds + 32768);
        for (int i = tid; i < NB * D; i += NTHREADS) sc[i] = fsilu(a.in[I_C][i]);
        __syncthreads();
        const float* wada = a.in[I_WADA];
        float* ada = (float*)(ws + WS_ADA);
        for (int nb = bid; nb < 9 * D / 64; nb += G) {
            const int n = nb * 64 + lane, k0 = wave * 128;
            float acc[8];
#pragma unroll
            for (int b = 0; b < 8; ++b) acc[b] = 0.f;
#pragma unroll 16
            for (int kk = 0; kk < 128; ++kk) { const float wv = wada[(size_t)(k0 + kk) * (9 * D) + n];
#pragma unroll
                for (int b = 0; b < 8; ++b) acc[b] += sc[b * D + k0 + kk] * wv; }
#pragma unroll
            for (int b = 0; b < 8; ++b) red[(wave * 8 + b) * 64 + lane] = acc[b];
            __syncthreads();
            { const int b = tid >> 6; float s = 0.f;
#pragma unroll
              for (int w = 0; w < 8; ++w) s += red[(w * 8 + b) * 64 + lane];
              ada[b * (9 * D) + n] = s + a.in[I_BADA][n]; }
            __syncthreads();
        }
    }
    if (bid == G - 1) {
        float* lbo = (float*)(ws + WS_LB); const float* ll = a.in[I_LBL];
        for (int c = tid; c < D; c += NTHREADS) lbo[c] = 1.0f / (1.0f + expf(ll[D + c] - ll[c]));
    }
    __syncthreads();
    LAS float* scr = (LAS float*)(lds + 49152 + wave * 8704);
    const int gw = bid * NWAVES + wave, NGW = G * NWAVES;
    constexpr int I_FI = (D / 64) * (2 * FF / 32), I_FO = (FF / 64) * (D / 32), I_MI = (D / 64) * (NMIX / 32), I_SQ = (D / 64) * (D / 32);
    constexpr int NITEMS = 2 * I_FI + 2 * I_FO + I_MI + 3 * I_SQ;
    for (int it = gw; it < NITEMS; it += NGW) {
        int r = it;
        if (r < I_MI) { p0_transpose_item(a.in[I_WMIX], D, NMIX, (bf16_t*)(ws + WS_WMIX), 2, scr, r, lane); continue; } r -= I_MI;
        if (r < I_FI) { p0_transpose_item(a.in[I_W1IN], D, 2 * FF, (bf16_t*)(ws + WS_W1IN), 1, scr, r, lane); continue; } r -= I_FI;
        if (r < I_FI) { p0_transpose_item(a.in[I_W2IN], D, 2 * FF, (bf16_t*)(ws + WS_W2IN), 1, scr, r, lane); continue; } r -= I_FI;
        if (r < I_FO) { p0_transpose_item(a.in[I_W1OUT], FF, D, (bf16_t*)(ws + WS_W1OUT), 0, scr, r, lane); continue; } r -= I_FO;
        if (r < I_FO) { p0_transpose_item(a.in[I_W2OUT], FF, D, (bf16_t*)(ws + WS_W2OUT), 0, scr, r, lane); continue; } r -= I_FO;
        if (r < I_SQ) { p0_transpose_item(a.in[I_WCO], D, D, (bf16_t*)(ws + WS_WCO), 0, scr, r, lane); continue; } r -= I_SQ;
        if (r < I_SQ) { p0_transpose_item(a.in[I_WHO], D, D, (bf16_t*)(ws + WS_WHO), 0, scr, r, lane); continue; } r -= I_SQ;
        p0_transpose_item(a.in[I_WMO], D, D, (bf16_t*)(ws + WS_WMO), 0, scr, r, lane);
    }
}

__device__ __forceinline__ int gm_row(int m) { return ((m >> 12) & 1) * MG + (m >> 13) * SG + (m & (SG - 1)); }

__device__ __forceinline__ void normmod_phase(const float* x, const float* ng, const float* ada, int shslot, int scslot, bf16_t* H, const Ctx& cx) {
    const int wave = cx.wave, lane = cx.lane; const int gw = cx.bid * NWAVES + wave, NGW = cx.G * NWAVES;
    constexpr int RB = 4;
    for (int m4 = gw; m4 < M / RB; m4 += NGW) {
        const int m0 = m4 * RB, b = m0 >> 13;
        f32x4 v[RB][4];
#pragma unroll
        for (int r = 0; r < RB; ++r) { const f32x4* xr = (const f32x4*)(x + (size_t)(m0 + r) * D) + lane;
#pragma unroll
            for (int j = 0; j < 4; ++j) v[r][j] = xr[64 * j]; }
        float rstd[RB];
#pragma unroll
        for (int r = 0; r < RB; ++r) { float s = 0.f;
#pragma unroll
            for (int j = 0; j < 4; ++j) s += (v[r][j].x * v[r][j].x + v[r][j].y * v[r][j].y) + (v[r][j].z * v[r][j].z + v[r][j].w * v[r][j].w);
            rstd[r] = rsqrtf(wave_sum(s) * (1.f / D) + EPS); }
        const float* sh = ada + (size_t)b * 9 * D + shslot * D; const float* sc = ada + (size_t)b * 9 * D + scslot * D;
#pragma unroll
        for (int j = 0; j < 4; ++j) { const int c = 4 * lane + 256 * j;
            const f32x4 gv = *(const f32x4*)(ng + c), scv = *(const f32x4*)(sc + c), shv = *(const f32x4*)(sh + c);
            const f32x4 mul = gv * (scv + 1.0f);
#pragma unroll
            for (int r = 0; r < RB; ++r) { const f32x4 h = v[r][j] * rstd[r] * mul + shv;
                u32x2 w; w.x = cvt_pk_bf16(h.x, h.y); w.y = cvt_pk_bf16(h.z, h.w); ((u32x2*)(H + (size_t)(m0 + r) * D) + lane)[64 * j] = w; } }
    }
}

template <bool HAS_NEXT, bool Y_GM, bool H_GM, bool XIN_BF, bool XOUT_BF>
__device__ __forceinline__ void res_phase(const bf16_t* Y, const void* xin_, void* xout_, float wres, const float* ada, int gslot, const float* ng_post,
                                          const float* ng_pre, int shslot, int scslot, bf16_t* H, const Ctx& cx) {
    const int wave = cx.wave, lane = cx.lane; const int gw = cx.bid * NWAVES + wave, NGW = cx.G * NWAVES;
    constexpr int RB = XIN_BF ? 4 : 2;
    for (int m4 = gw; m4 < M / RB; m4 += NGW) {
        const int m0 = m4 * RB, b = m0 >> 13;
        const size_t y0 = Y_GM ? (size_t)gm_row(m0) : (size_t)m0;
        u32x2 yw[RB][4]; f32x4 xv[RB][4];
#pragma unroll
        for (int r = 0; r < RB; ++r) { const u32x2* yr = (const u32x2*)(Y + (y0 + r) * D) + lane;
#pragma unroll
            for (int j = 0; j < 4; ++j) { yw[r][j] = yr[64 * j];
                if (XIN_BF) { const u32x2 xw = ((const u32x2*)((const bf16_t*)xin_ + (size_t)(m0 + r) * D) + lane)[64 * j]; xv[r][j] = (f32x4){bflo(xw.x), bfhi(xw.x), bflo(xw.y), bfhi(xw.y)}; }
                else xv[r][j] = ((const f32x4*)((const float*)xin_ + (size_t)(m0 + r) * D) + lane)[64 * j]; } }
        float rstd[RB];
#pragma unroll
        for (int r = 0; r < RB; ++r) { float s = 0.f;
#pragma unroll
            for (int j = 0; j < 4; ++j) { const f32x4 y = (f32x4){bflo(yw[r][j].x), bfhi(yw[r][j].x), bflo(yw[r][j].y), bfhi(yw[r][j].y)}; s += (y.x * y.x + y.y * y.y) + (y.z * y.z + y.w * y.w); }
            rstd[r] = rsqrtf(wave_sum(s) * (1.f / D) + EPS) * wres; }
        const float* gp = ada + (size_t)b * 9 * D + gslot * D;
        float s2[RB];
#pragma unroll
        for (int r = 0; r < RB; ++r) s2[r] = 0.f;
#pragma unroll
        for (int j = 0; j < 4; ++j) { const int c = 4 * lane + 256 * j;
            const f32x4 gn = *(const f32x4*)(gp + c) * *(const f32x4*)(ng_post + c);
#pragma unroll
            for (int r = 0; r < RB; ++r) { const f32x4 y = (f32x4){bflo(yw[r][j].x), bfhi(yw[r][j].x), bflo(yw[r][j].y), bfhi(yw[r][j].y)};
                const f32x4 xn = xv[r][j] + gn * (y * rstd[r]); xv[r][j] = xn;
                if (XOUT_BF) { u32x2 xw; xw.x = cvt_pk_bf16(xn.x, xn.y); xw.y = cvt_pk_bf16(xn.z, xn.w); ((u32x2*)((bf16_t*)xout_ + (size_t)(m0 + r) * D) + lane)[64 * j] = xw; }
                else ((f32x4*)((float*)xout_ + (size_t)(m0 + r) * D) + lane)[64 * j] = xn;
                s2[r] += (xn.x * xn.x + xn.y * xn.y) + (xn.z * xn.z + xn.w * xn.w); } }
        if (HAS_NEXT) {
            float rstd2[RB];
#pragma unroll
            for (int r = 0; r < RB; ++r) rstd2[r] = rsqrtf(wave_sum(s2[r]) * (1.f / D) + EPS);
            const float* sh = ada + (size_t)b * 9 * D + shslot * D; const float* sc = ada + (size_t)b * 9 * D + scslot * D;
            const size_t h0 = H_GM ? (size_t)gm_row(m0) : (size_t)m0;
#pragma unroll
            for (int j = 0; j < 4; ++j) { const int c = 4 * lane + 256 * j;
                const f32x4 gv = *(const f32x4*)(ng_pre + c), scv = *(const f32x4*)(sc + c), shv = *(const f32x4*)(sh + c);
                const f32x4 mul = gv * (scv + 1.0f);
#pragma unroll
                for (int r = 0; r < RB; ++r) { const f32x4 h = xv[r][j] * rstd2[r] * mul + shv;
                    u32x2 w; w.x = cvt_pk_bf16(h.x, h.y); w.y = cvt_pk_bf16(h.z, h.w); ((u32x2*)(H + (h0 + r) * D) + lane)[64 * j] = w; } }
        }
    }
}

__device__ __forceinline__ void conv_phase(bf16_t* CB, const bf16_t* P, bf16_t* HALO, const float* cw, const float* cbias, int g, const Ctx& cx) {
    const int wave = cx.wave, lane = cx.lane; const int gw = cx.bid * NWAVES + wave, NGW = cx.G * NWAVES;
    constexpr int RB = 4;
    for (int r4 = gw; r4 < MG / RB; r4 += NGW) {
        const int r0 = r4 * RB, b = r0 >> 12, t0 = r0 & (SG - 1);
        u32x4 cb[RB][2], p[RB + 2][2];
#pragma unroll
        for (int j = 0; j < 2; ++j) { const int c = 8 * lane + 512 * j;
#pragma unroll
            for (int r = 0; r < RB; ++r) { cb[r][j] = *(const u32x4*)(CB + (size_t)(r0 + r) * D + c); p[r + 2][j] = *(const u32x4*)(P + (size_t)(r0 + r) * D + c); }
            if (t0 >= 2) { p[0][j] = *(const u32x4*)(P + (size_t)(r0 - 2) * D + c); p[1][j] = *(const u32x4*)(P + (size_t)(r0 - 1) * D + c); }
            else if (g > 0) { p[0][j] = *(const u32x4*)(HALO + (size_t)(b * 2 + 0) * D + c); p[1][j] = *(const u32x4*)(HALO + (size_t)(b * 2 + 1) * D + c); }
            else { p[0][j] = (u32x4){0u, 0u, 0u, 0u}; p[1][j] = (u32x4){0u, 0u, 0u, 0u}; } }
        if (g == 0 && t0 == SG - RB) {
#pragma unroll
            for (int j = 0; j < 2; ++j) { const int c = 8 * lane + 512 * j;
                *(u32x4*)(HALO + (size_t)(b * 2 + 0) * D + c) = p[RB][j]; *(u32x4*)(HALO + (size_t)(b * 2 + 1) * D + c) = p[RB + 1][j]; } }
#pragma unroll
        for (int j = 0; j < 2; ++j) { const int c = 8 * lane + 512 * j;
            float w0[8], w1[8], w2[8], bs[8];
#pragma unroll
            for (int h = 0; h < 2; ++h) { const f32x4 a0 = *(const f32x4*)(cw + c + 4 * h), a1 = *(const f32x4*)(cw + D + c + 4 * h), a2 = *(const f32x4*)(cw + 2 * D + c + 4 * h), bb = *(const f32x4*)(cbias + c + 4 * h);
#pragma unroll
                for (int e = 0; e < 4; ++e) { w0[4 * h + e] = a0[e]; w1[4 * h + e] = a1[e]; w2[4 * h + e] = a2[e]; bs[4 * h + e] = bb[e]; } }
#pragma unroll
            for (int r = 0; r < RB; ++r) {
                const unsigned cbw[4] = {cb[r][j].x, cb[r][j].y, cb[r][j].z, cb[r][j].w}, p0w[4] = {p[r + 2][j].x, p[r + 2][j].y, p[r + 2][j].z, p[r + 2][j].w},
                               p1w[4] = {p[r + 1][j].x, p[r + 1][j].y, p[r + 1][j].z, p[r + 1][j].w}, p2w[4] = {p[r][j].x, p[r][j].y, p[r][j].z, p[r][j].w};
                float r8[8];
#pragma unroll
                for (int e = 0; e < 4; ++e) {
                    r8[2 * e] = bflo(cbw[e]) * (w0[2 * e] * bflo(p2w[e]) + w1[2 * e] * bflo(p1w[e]) + w2[2 * e] * bflo(p0w[e]) + bs[2 * e]);
                    r8[2 * e + 1] = bfhi(cbw[e]) * (w0[2 * e + 1] * bfhi(p2w[e]) + w1[2 * e + 1] * bfhi(p1w[e]) + w2[2 * e + 1] * bfhi(p0w[e]) + bs[2 * e + 1]);
                }
                u32x4 w; w.x = cvt_pk_bf16(r8[0], r8[1]); w.y = cvt_pk_bf16(r8[2], r8[3]); w.z = cvt_pk_bf16(r8[4], r8[5]); w.w = cvt_pk_bf16(r8[6], r8[7]);
                *(u32x4*)(CB + (size_t)(r0 + r) * D + c) = w; } }
    }
}

__device__ __forceinline__ void og_phase(const float* O, const bf16_t* GS, const float* gain, bf16_t* OG, const Ctx& cx) {
    const int wave = cx.wave, lane = cx.lane; const int gw = cx.bid * NWAVES + wave, NGW = cx.G * NWAVES;
    constexpr int RB = 4;
    const int c = 16 * lane;
    for (int r4 = gw; r4 < MG / RB; r4 += NGW) {
        const int r0 = r4 * RB;
        f32x4 o[RB][4]; u32x4 gsv[RB][2]; u32x4 ow_[RB][2];
#pragma unroll
        for (int r = 0; r < RB; ++r) { const bf16_t* op = (const bf16_t*)O + (size_t)(r0 + r) * D + c;
            ow_[r][0] = *(const u32x4*)op; ow_[r][1] = *(const u32x4*)(op + 8);
            gsv[r][0] = *(const u32x4*)(GS + (size_t)(r0 + r) * D + c); gsv[r][1] = *(const u32x4*)(GS + (size_t)(r0 + r) * D + c + 8); }
        f32x4 gn[4];
#pragma unroll
        for (int j = 0; j < 4; ++j) gn[j] = *(const f32x4*)(gain + c + 4 * j);
#pragma unroll
        for (int r = 0; r < RB; ++r) { float s = 0.f;
            { const unsigned w8[8] = {ow_[r][0].x, ow_[r][0].y, ow_[r][0].z, ow_[r][0].w, ow_[r][1].x, ow_[r][1].y, ow_[r][1].z, ow_[r][1].w};
#pragma unroll
              for (int j = 0; j < 4; ++j) o[r][j] = (f32x4){bflo(w8[2 * j]), bfhi(w8[2 * j]), bflo(w8[2 * j + 1]), bfhi(w8[2 * j + 1])}; }
#pragma unroll
            for (int j = 0; j < 4; ++j) s += (o[r][j].x * o[r][j].x + o[r][j].y * o[r][j].y) + (o[r][j].z * o[r][j].z + o[r][j].w * o[r][j].w);
            s += __shfl_xor(s, 1); s += __shfl_xor(s, 2); s += __shfl_xor(s, 4);
            const float rstd = rsqrtf(s * (1.f / 128.f) + EPS);
            const unsigned gw4[8] = {gsv[r][0].x, gsv[r][0].y, gsv[r][0].z, gsv[r][0].w, gsv[r][1].x, gsv[r][1].y, gsv[r][1].z, gsv[r][1].w};
            unsigned ow[8];
#pragma unroll
            for (int j = 0; j < 4; ++j) {
                const float a0 = o[r][j].x * rstd * gn[j].x * bflo(gw4[2 * j]), a1 = o[r][j].y * rstd * gn[j].y * bfhi(gw4[2 * j]);
                const float a2 = o[r][j].z * rstd * gn[j].z * bflo(gw4[2 * j + 1]), a3 = o[r][j].w * rstd * gn[j].w * bfhi(gw4[2 * j + 1]);
                ow[2 * j] = cvt_pk_bf16(a0, a1); ow[2 * j + 1] = cvt_pk_bf16(a2, a3); }
            *(u32x4*)(OG + (size_t)(r0 + r) * D + c) = (u32x4){ow[0], ow[1], ow[2], ow[3]};
            *(u32x4*)(OG + (size_t)(r0 + r) * D + c + 8) = (u32x4){ow[4], ow[5], ow[6], ow[7]}; }
    }
}

namespace scan {
constexpr int SQB = 272;
constexpr int SVB = 144;
constexpr int L_QD = 0, L_QT = L_QD + 64 * SQB, L_KT0 = L_QT + 64 * SQB, L_KT1 = L_KT0 + 32 * SQB, L_ST = L_KT1 + 64 * SQB, L_VT = L_ST + 2 * 32 * SQB,
              L_TQ = L_VT + 2 * 32 * SVB, L_TK = L_TQ + 64 * SQB, L_TL = L_TK + 64 * SQB, L_END = L_TL + 64 * SQB;
static_assert(L_END <= MISC_OFF, "scan LDS map");
#define LBAR() do { asm volatile("s_waitcnt lgkmcnt(0)" ::: "memory"); __builtin_amdgcn_s_barrier(); asm volatile("" ::: "memory"); } while (0)
#define MF(a, b, c) __builtin_amdgcn_mfma_f32_16x16x32_bf16((a), (b), (c), 0, 0, 0)

__device__ __forceinline__ void scan_phase(LAS unsigned char* lds, const bf16_t* Qb, const bf16_t* LFb, const bf16_t* KKb, const bf16_t* Vb, float* Ob, float* SBUF, int g, const Ctx& cx) {
    const int tid = cx.tid, w = cx.wave, lane = cx.lane;
    const int l15 = lane & 15, quad = lane >> 4;
    const f32x4 Z4 = (f32x4){0.f, 0.f, 0.f, 0.f};
    for (int unit = cx.bid; unit < 256; unit += cx.G) {
        const int xcd = unit & 7, jj0 = unit >> 3, vs = jj0 & 3, bh = xcd * 8 + (jj0 >> 2), b = bh >> 3, h = bh & 7;
        const size_t rowbase = (size_t)b * SG;
        const int colq = h * 128, colv = h * 128 + vs * 32;
        const int kc = colq + 16 * w + l15;
        const int kr = colq + 16 * w + 4 * quad;
        bf16x8 ONES, M0, M1, SEL;
#pragma unroll
        for (int j = 0; j < 8; ++j) { ONES[j] = (short)0x3F80; M0[j] = (8 * quad + j <= l15) ? (short)0x3F80 : (short)0; M1[j] = (8 * quad + j <= 16 + l15) ? (short)0x3F80 : (short)0; SEL[j] = (quad < 2) ? (short)0x3F80 : (short)0; }
        f32x4 Sacc[2];
        float* sb = SBUF + (size_t)bh * 128 * 128;
#pragma unroll
        for (int vt = 0; vt < 2; ++vt)
#pragma unroll
            for (int j = 0; j < 4; ++j) Sacc[vt][j] = (g == 0) ? 0.f : sb[(16 * w + 4 * quad + j) * 128 + vs * 32 + 16 * vt + l15];
#pragma unroll
        for (int vt = 0; vt < 2; ++vt) { u32x2 sw; sw.x = cvt_pk_bf16(Sacc[vt][0], Sacc[vt][1]); sw.y = cvt_pk_bf16(Sacc[vt][2], Sacc[vt][3]);
            *(LAS u32x2*)(lds + L_ST + (16 * vt + l15) * SQB + (16 * w + 4 * quad) * 2) = sw; }
        u32x4 rq[2], rk[2], rl[2]; u32x2 rv;
        const int vrow = tid >> 3, vvc = tid & 7;
        const int prow0 = tid >> 4, pkc = tid & 15;
        const int pp0 = ((pkc + 2 * (prow0 >> 3)) & 15) * 16, pp1 = ((pkc + 2 * ((prow0 + 32) >> 3)) & 15) * 16;
#define SC_LOAD(c) do { const size_t r0_ = rowbase + (size_t)(c) * CH; \
            rq[0] = *(const u32x4*)(Qb + (r0_ + prow0) * D + colq + 8 * pkc); rq[1] = *(const u32x4*)(Qb + (r0_ + prow0 + 32) * D + colq + 8 * pkc); \
            rk[0] = *(const u32x4*)(KKb + (r0_ + prow0) * D + colq + 8 * pkc); rk[1] = *(const u32x4*)(KKb + (r0_ + prow0 + 32) * D + colq + 8 * pkc); \
            rl[0] = *(const u32x4*)(LFb + (r0_ + prow0) * D + colq + 8 * pkc); rl[1] = *(const u32x4*)(LFb + (r0_ + prow0 + 32) * D + colq + 8 * pkc); \
            rv = *(const u32x2*)(Vb + (r0_ + vrow) * D + colv + 4 * vvc); } while (0)
#define SC_STOREV(c) do { LAS unsigned char* vt_ = lds + L_VT + ((c) & 1) * 32 * SVB + vrow * 2; \
            *(LAS unsigned short*)(vt_ + (4 * vvc + 0) * SVB) = (unsigned short)(rv.x & 0xffffu); *(LAS unsigned short*)(vt_ + (4 * vvc + 1) * SVB) = (unsigned short)(rv.x >> 16); \
            *(LAS unsigned short*)(vt_ + (4 * vvc + 2) * SVB) = (unsigned short)(rv.y & 0xffffu); *(LAS unsigned short*)(vt_ + (4 * vvc + 3) * SVB) = (unsigned short)(rv.y >> 16); \
            *(LAS u32x4*)(lds + L_TQ + prow0 * SQB + pp0) = rq[0]; *(LAS u32x4*)(lds + L_TQ + (prow0 + 32) * SQB + pp1) = rq[1]; \
            *(LAS u32x4*)(lds + L_TK + prow0 * SQB + pp0) = rk[0]; *(LAS u32x4*)(lds + L_TK + (prow0 + 32) * SQB + pp1) = rk[1]; \
            *(LAS u32x4*)(lds + L_TL + prow0 * SQB + pp0) = rl[0]; *(LAS u32x4*)(lds + L_TL + (prow0 + 32) * SQB + pp1) = rl[1]; } while (0)
        bf16x8 LF0, LF1; float kcf[16]; u32x2 qc[4], kc4[4];
#define TCOL(r_, kk_) (((kk_) + 16 * ((r_) >> 3)) & 127)
#define SC_CONSUME() do { const int kl_ = 16 * w + l15, kq_ = 16 * w + 4 * quad; \
            const LAS unsigned short* tl_ = (const LAS unsigned short*)(lds + L_TL); const LAS unsigned short* tk_ = (const LAS unsigned short*)(lds + L_TK); \
            unsigned short l_[16]; \
            _Pragma("unroll") for (int j_ = 0; j_ < 8; ++j_) { l_[j_] = tl_[(8 * quad + j_) * (SQB / 2) + TCOL(8 * quad, kl_)]; l_[8 + j_] = tl_[(32 + 8 * quad + j_) * (SQB / 2) + TCOL(32 + 8 * quad, kl_)]; } \
            _Pragma("unroll") for (int t_ = 0; t_ < 4; ++t_) { _Pragma("unroll") for (int j_ = 0; j_ < 4; ++j_) kcf[4 * t_ + j_] = bf2f((unsigned)tk_[(16 * t_ + 4 * quad + j_) * (SQB / 2) + TCOL(16 * t_ + 4 * quad, kl_)]); \
                qc[t_] = *(const LAS u32x2*)(lds + L_TQ + (16 * t_ + l15) * SQB + TCOL(16 * t_ + l15, kq_) * 2); kc4[t_] = *(const LAS u32x2*)(lds + L_TK + (16 * t_ + l15) * SQB + TCOL(16 * t_ + l15, kq_) * 2); } \
            u32x4 a_, b_; \
            a_.x = (unsigned)l_[0] | ((unsigned)l_[1] << 16); a_.y = (unsigned)l_[2] | ((unsigned)l_[3] << 16); a_.z = (unsigned)l_[4] | ((unsigned)l_[5] << 16); a_.w = (unsigned)l_[6] | ((unsigned)l_[7] << 16); \
            b_.x = (unsigned)l_[8] | ((unsigned)l_[9] << 16); b_.y = (unsigned)l_[10] | ((unsigned)l_[11] << 16); b_.z = (unsigned)l_[12] | ((unsigned)l_[13] << 16); b_.w = (unsigned)l_[14] | ((unsigned)l_[15] << 16); \
            LF0 = __builtin_bit_cast(bf16x8, a_); LF1 = __builtin_bit_cast(bf16x8, b_); } while (0)
        SC_LOAD(0); SC_STOREV(0);
        f32x4 oprev = Z4;
        for (int c = 0; c < NCH; ++c) {
            LBAR();
            { const int cn = (c + 1 < NCH) ? c + 1 : NCH - 1; SC_LOAD(cn); }
            asm volatile("" ::: "memory");
            {
                const int cp = c > 0 ? c - 1 : 0;
                float* op = Ob + (rowbase + (size_t)cp * CH + 16 * (w >> 1) + 4 * quad) * D + colv + 16 * (w & 1) + l15;
#pragma unroll
                for (int j = 0; j < 4; ++j) op[(size_t)j * D] = oprev[j];
            }
            asm volatile("" ::: "memory");
            SC_CONSUME();
            f32x4 aC[4], aR[4], alC, alR, r0, r1;
            {
                const f32x4 X = MF(ONES, LF0, Z4);
                aC[0] = MF(M0, LF0, Z4); aC[1] = MF(M1, LF0, Z4); aC[2] = MF(M0, LF1, X); aC[3] = MF(M1, LF1, X); alC = MF(ONES, LF1, X);
                const f32x4 Y = MF(LF0, ONES, Z4);
                aR[0] = MF(LF0, M0, Z4); aR[1] = MF(LF0, M1, Z4); aR[2] = MF(LF1, M0, Y); aR[3] = MF(LF1, M1, Y); alR = MF(LF1, ONES, Y);
                r0 = MF(LF0, SEL, Z4); r1 = MF(LF1, SEL, Y);
            }
            bf16x8 KdA[2];
            {
                float kd[16];
#pragma unroll
                for (int tt = 0; tt < 4; ++tt)
#pragma unroll
                    for (int j = 0; j < 4; ++j) kd[4 * tt + j] = kcf[4 * tt + j] * __expf(alC[j] - aC[tt][j]);
                u32x4 p0, p1;
                p0.x = cvt_pk_bf16(kd[0], kd[1]); p0.y = cvt_pk_bf16(kd[2], kd[3]); p0.z = cvt_pk_bf16(kd[4], kd[5]); p0.w = cvt_pk_bf16(kd[6], kd[7]);
                p1.x = cvt_pk_bf16(kd[8], kd[9]); p1.y = cvt_pk_bf16(kd[10], kd[11]); p1.z = cvt_pk_bf16(kd[12], kd[13]); p1.w = cvt_pk_bf16(kd[14], kd[15]);
                KdA[0] = __builtin_bit_cast(bf16x8, p0); KdA[1] = __builtin_bit_cast(bf16x8, p1);
            }
            f32x4 dk;
            {
                f32x4 er0, er1, c10;
#pragma unroll
                for (int j = 0; j < 4; ++j) { er0[j] = __expf(r0[j]); er1[j] = __expf(r1[j]); c10[j] = __expf(r1[j] - r0[j]); dk[j] = __expf(alR[j]); }
#pragma unroll
                for (int tt = 0; tt < 4; ++tt) {
                    const f32x4 rI = (tt < 2) ? r0 : r1, erI = (tt < 2) ? er0 : er1;
                    const float qf[4] = {bflo(qc[tt].x), bfhi(qc[tt].x), bflo(qc[tt].y), bfhi(qc[tt].y)}, kf[4] = {bflo(kc4[tt].x), bfhi(kc4[tt].x), bflo(kc4[tt].y), bfhi(kc4[tt].y)};
                    float qd[4], qt[4], kt[4], k1[4];
#pragma unroll
                    for (int j = 0; j < 4; ++j) { const float d = fminf(fmaxf(aR[tt][j] - rI[j], -80.f), 80.f);
                        qt[j] = qf[j] * __expf(d); qd[j] = qt[j] * erI[j]; kt[j] = kf[j] * __expf(-d); k1[j] = kt[j] * c10[j]; }
                    const int off = (16 * tt + l15) * SQB + (16 * w + 4 * quad) * 2;
                    u32x2 wq, wt, wk;
                    wq.x = cvt_pk_bf16(qd[0], qd[1]); wq.y = cvt_pk_bf16(qd[2], qd[3]); wt.x = cvt_pk_bf16(qt[0], qt[1]); wt.y = cvt_pk_bf16(qt[2], qt[3]); wk.x = cvt_pk_bf16(kt[0], kt[1]); wk.y = cvt_pk_bf16(kt[2], kt[3]);
                    *(LAS u32x2*)(lds + L_QD + off) = wq;
                    *(LAS u32x2*)(lds + L_QT + off) = wt;
                    if (tt < 2) { u32x2 w1; w1.x = cvt_pk_bf16(k1[0], k1[1]); w1.y = cvt_pk_bf16(k1[2], k1[3]);
                        *(LAS u32x2*)(lds + L_KT0 + off) = wk; *(LAS u32x2*)(lds + L_KT1 + off) = w1; }
                    else *(LAS u32x2*)(lds + L_KT1 + off) = wk;
                }
            }
            LBAR();
            f32x4 o = Z4;
            const int ti = w >> 1, vt = w & 1;
            {
                const LAS unsigned char* STc = lds + L_ST + (c & 1) * 32 * SQB;
                LAS unsigned char* STn = lds + L_ST + ((c + 1) & 1) * 32 * SQB;
                const LAS unsigned char* VTc = lds + L_VT + (c & 1) * 32 * SVB;
#pragma unroll
                for (int ks = 0; ks < 4; ++ks) {
                    const bf16x8 af = *(const LAS bf16x8*)(lds + L_QD + (16 * ti + l15) * SQB + (8 * quad + 32 * ks) * 2);
                    const bf16x8 bfr = *(const LAS bf16x8*)(STc + (16 * vt + l15) * SQB + (8 * quad + 32 * ks) * 2);
                    o = MF(af, bfr, o);
                }
                f32x4 pT[4];
                const LAS unsigned char* KT = (ti < 2) ? (lds + L_KT0) : (lds + L_KT1);
                bf16x8 qf[4];
#pragma unroll
                for (int ks = 0; ks < 4; ++ks) qf[ks] = *(const LAS bf16x8*)(lds + L_QT + (16 * ti + l15) * SQB + (8 * quad + 32 * ks) * 2);
#pragma unroll
                for (int sj = 0; sj < 4; ++sj) {
                    bf16x8 kf[4];
#pragma unroll
                    for (int ks = 0; ks < 4; ++ks) kf[ks] = *(const LAS bf16x8*)(KT + (16 * sj + l15) * SQB + (8 * quad + 32 * ks) * 2);
                    pT[sj] = Z4;
#pragma unroll
                    for (int ks = 0; ks < 4; ++ks) pT[sj] = MF(kf[ks], qf[ks], pT[sj]);
                }
#pragma unroll
                for (int sj = 0; sj < 4; ++sj)
#pragma unroll
                    for (int j = 0; j < 4; ++j) { const bool keep = (sj < ti) || (sj == ti && 4 * quad + j <= l15); pT[sj][j] = keep ? pT[sj][j] : 0.f; }
#pragma unroll
                for (int pp = 0; pp < 2; ++pp) {
                    u32x4 pa; pa.x = cvt_pk_bf16(pT[2 * pp][0], pT[2 * pp][1]); pa.y = cvt_pk_bf16(pT[2 * pp][2], pT[2 * pp][3]);
                    pa.z = cvt_pk_bf16(pT[2 * pp + 1][0], pT[2 * pp + 1][1]); pa.w = cvt_pk_bf16(pT[2 * pp + 1][2], pT[2 * pp + 1][3]);
                    const LAS unsigned char* vp = VTc + (16 * vt + l15) * SVB + (32 * pp + 4 * quad) * 2;
                    const u32x2 v0 = *(const LAS u32x2*)vp, v1 = *(const LAS u32x2*)(vp + 32);
                    const u32x4 vb = (u32x4){v0.x, v0.y, v1.x, v1.y};
                    o = MF(__builtin_bit_cast(bf16x8, pa), __builtin_bit_cast(bf16x8, vb), o);
                }
#pragma unroll
                for (int v2 = 0; v2 < 2; ++v2) {
#pragma unroll
                    for (int j = 0; j < 4; ++j) Sacc[v2][j] *= dk[j];
#pragma unroll
                    for (int ks = 0; ks < 2; ++ks) {
                        const LAS unsigned char* vp = VTc + (16 * v2 + l15) * SVB + (32 * ks + 4 * quad) * 2;
                        const u32x2 v0 = *(const LAS u32x2*)vp, v1 = *(const LAS u32x2*)(vp + 32);
                        const u32x4 vb = (u32x4){v0.x, v0.y, v1.x, v1.y};
                        Sacc[v2] = MF(KdA[ks], __builtin_bit_cast(bf16x8, vb), Sacc[v2]);
                    }
                    u32x2 sw; sw.x = cvt_pk_bf16(Sacc[v2][0], Sacc[v2][1]); sw.y = cvt_pk_bf16(Sacc[v2][2], Sacc[v2][3]);
                    *(LAS u32x2*)(STn + (16 * v2 + l15) * SQB + (16 * w + 4 * quad) * 2) = sw;
                }
            }
            SC_STOREV(c + 1);
            oprev = o;
        }
        {
            float* op = Ob + (rowbase + (size_t)(NCH - 1) * CH + 16 * (w >> 1) + 4 * quad) * D + colv + 16 * (w & 1) + l15;
#pragma unroll
            for (int j = 0; j < 4; ++j) op[(size_t)j * D] = oprev[j];
        }
        if (g == 0) {
#pragma unroll
            for (int vt = 0; vt < 2; ++vt)
#pragma unroll
                for (int j = 0; j < 4; ++j) sb[(16 * w + 4 * quad + j) * 128 + vs * 32 + 16 * vt + l15] = Sacc[vt][j];
        }
        __syncthreads();
#undef SC_LOAD
#undef SC_STOREV
#undef SC_CONSUME
#undef TCOL
    }
}
}

namespace scan2 {
constexpr int SQB = 272, SVR = 288, NSEG = 4, CPS = NCH / NSEG;
constexpr int L_QD = 0, L_QT = L_QD + 64 * SQB, L_KT0 = L_QT + 64 * SQB, L_KT1 = L_KT0 + 32 * SQB, L_ST = L_KT1 + 64 * SQB, L_VT = L_ST + 128 * SQB,
              L_TQ = L_VT + 64 * SVR, L_TL = L_TQ + 64 * SQB, L_END = L_TL + 64 * SQB;
static_assert(L_END <= MISC_OFF, "scan2 LDS map");
#define LBAR() do { asm volatile("s_waitcnt lgkmcnt(0)" ::: "memory"); __builtin_amdgcn_s_barrier(); asm volatile("" ::: "memory"); } while (0)
#define MF(a, b, c) __builtin_amdgcn_mfma_f32_16x16x32_bf16((a), (b), (c), 0, 0, 0)
#define TCOL(r_, kk_) (((kk_) + 16 * ((r_) >> 3)) & 127)
#define TRR(p_) __builtin_bit_cast(u32x2, __builtin_amdgcn_ds_read_tr16_b64_v4i16((LAS s16x4*)(p_)))

template <bool FULL>
__device__ __forceinline__ void scan_pass(LAS unsigned char* lds, const bf16_t* Qb, const bf16_t* LFb, const bf16_t* KKb, const bf16_t* Vb, float* Ob, float* SBUF, float* SLOC, float* PLOC, int g, const Ctx& cx) {
    const int tid = cx.tid, w = cx.wave, lane = cx.lane;
    const int l15 = lane & 15, quad = lane >> 4;
    const f32x4 Z4 = (f32x4){0.f, 0.f, 0.f, 0.f};
    for (int unit = cx.bid; unit < 256; unit += cx.G) {
        const int xcd = unit & 7, jj0 = unit >> 3, seg = jj0 & 3, bh = xcd * 8 + (jj0 >> 2), b = bh >> 3, h = bh & 7;
        const size_t rowbase = (size_t)b * SG + (size_t)seg * CPS * CH;
        const int colq = h * 128;
        const int kc = colq + 16 * w + l15;
        bf16x8 ONES, M0, M1, SEL;
#pragma unroll
        for (int j = 0; j < 8; ++j) { ONES[j] = (short)0x3F80; M0[j] = (8 * quad + j <= l15) ? (short)0x3F80 : (short)0; M1[j] = (8 * quad + j <= 16 + l15) ? (short)0x3F80 : (short)0; SEL[j] = (quad < 2) ? (short)0x3F80 : (short)0; }
        f32x4 Sacc[8];
        f32x4 sumal = Z4;
        float* sb = SBUF + (size_t)bh * 128 * 128;
        if (FULL) {
#pragma unroll
            for (int vt = 0; vt < 8; ++vt)
#pragma unroll
                for (int j = 0; j < 4; ++j) Sacc[vt][j] = (g == 0) ? 0.f : sb[(16 * w + 4 * quad + j) * 128 + 16 * vt + l15];
            for (int sp = 0; sp < seg; ++sp) {
                const float* sl = SLOC + (size_t)(bh * NSEG + sp) * 128 * 128; const float* pl = PLOC + (size_t)(bh * NSEG + sp) * 128;
                const f32x4 pv = *(const f32x4*)(pl + 16 * w + 4 * quad);
#pragma unroll
                for (int vt = 0; vt < 8; ++vt)
#pragma unroll
                    for (int j = 0; j < 4; ++j) Sacc[vt][j] = pv[j] * Sacc[vt][j] + sl[(16 * w + 4 * quad + j) * 128 + 16 * vt + l15];
            }
#pragma unroll
            for (int vt = 0; vt < 8; ++vt) { u32x2 sw; sw.x = cvt_pk_bf16(Sacc[vt][0], Sacc[vt][1]); sw.y = cvt_pk_bf16(Sacc[vt][2], Sacc[vt][3]);
                *(LAS u32x2*)(lds + L_ST + (16 * vt + l15) * SQB + (16 * w + 4 * quad) * 2) = sw; }
        } else {
#pragma unroll
            for (int vt = 0; vt < 8; ++vt) Sacc[vt] = Z4;
        }
        u32x4 rq[2], rvv[2], rl[2];
#define S2_LOAD(c) do { const size_t r0_ = rowbase + (size_t)(c) * CH; int t2_ = tid; asm volatile("" : "+v"(t2_)); \
            const unsigned toff = (unsigned)((t2_ >> 4) * D + colq + 8 * (t2_ & 15)); \
            const bf16_t* qb_ = Qb + r0_ * D; const bf16_t* vb_ = Vb + r0_ * D; const bf16_t* lb_ = LFb + r0_ * D; \
            if (FULL) { rq[0] = *(const u32x4*)(qb_ + toff); rq[1] = *(const u32x4*)(qb_ + 32 * D + toff); } \
            rvv[0] = *(const u32x4*)(vb_ + toff); rvv[1] = *(const u32x4*)(vb_ + 32 * D + toff); \
            rl[0] = *(const u32x4*)(lb_ + toff); rl[1] = *(const u32x4*)(lb_ + 32 * D + toff); } while (0)
#define S2_STORE(VB_, TB_) do { int t3_ = tid; asm volatile("" : "+v"(t3_)); const int prow0 = t3_ >> 4, pkc = t3_ & 15; \
            const int pp0 = ((pkc + 2 * (prow0 >> 3)) & 15) * 16, pp1 = ((pkc + 2 * ((prow0 + 32) >> 3)) & 15) * 16; \
            *(LAS u32x4*)(lds + (VB_) + prow0 * SVR + pkc * 16) = rvv[0]; *(LAS u32x4*)(lds + (VB_) + (prow0 + 32) * SVR + pkc * 16) = rvv[1]; \
            if (FULL) { *(LAS u32x4*)(lds + L_TQ + prow0 * SQB + pp0) = rq[0]; *(LAS u32x4*)(lds + L_TQ + (prow0 + 32) * SQB + pp1) = rq[1]; } \
            *(LAS u32x4*)(lds + (TB_) + prow0 * SQB + pkc * 16) = rl[0]; *(LAS u32x4*)(lds + (TB_) + (prow0 + 32) * SQB + pkc * 16) = rl[1]; } while (0)
        S2_LOAD(0); S2_STORE(L_VT, L_TL);
        bf16x8 LF0, LF1;
#define S2_LF(TB_) do { const LAS unsigned char* tp_ = lds + (TB_) + (8 * quad + (l15 >> 2)) * SQB + (16 * w + 4 * (l15 & 3)) * 2; \
            const u32x2 x0_ = TRR(tp_), x1_ = TRR(tp_ + 4 * SQB), x2_ = TRR(tp_ + 32 * SQB), x3_ = TRR(tp_ + 36 * SQB); \
            LF0 = __builtin_bit_cast(bf16x8, (u32x4){x0_.x, x0_.y, x1_.x, x1_.y}); LF1 = __builtin_bit_cast(bf16x8, (u32x4){x2_.x, x2_.y, x3_.x, x3_.y}); } while (0)
        const int l15o = l15, quado = quad;
        for (int c = 0; c < CPS; ++c) {
            int l15 = l15o, quad = quado; asm volatile("" : "+v"(l15), "+v"(quad));
            const int vtb = (!FULL && (c & 1)) ? L_QD : L_VT, tlb = (!FULL && (c & 1)) ? (L_QD + 64 * SVR) : L_TL;
            const int vtn = (!FULL && !(c & 1)) ? L_QD : L_VT, tln = (!FULL && !(c & 1)) ? (L_QD + 64 * SVR) : L_TL;
            LBAR();
            { const int cn = (c + 1 < CPS) ? c + 1 : CPS - 1; S2_LOAD(cn); }
            S2_LF(tlb);
            float kcf[16]; u32x2 qc[4], kc4[4];
            {
                const int kl_ = 16 * w + l15, kq_ = 16 * w + 4 * quad;
#pragma unroll
                for (int t_ = 0; t_ < 4; ++t_) {
                    { const int s0_ = 16 * t_ + 4 * quad; const u32x2 kx_ = TRR(lds + tlb + (s0_ + (l15 >> 2)) * SQB + (16 * w + 4 * (l15 & 3)) * 2);
                      kcf[4 * t_ + 0] = 1.0f - __expf(bflo(kx_.x)); kcf[4 * t_ + 1] = 1.0f - __expf(bfhi(kx_.x)); kcf[4 * t_ + 2] = 1.0f - __expf(bflo(kx_.y)); kcf[4 * t_ + 3] = 1.0f - __expf(bfhi(kx_.y)); }
                    if (FULL) { qc[t_] = *(const LAS u32x2*)(lds + L_TQ + (16 * t_ + l15) * SQB + TCOL(16 * t_ + l15, kq_) * 2); kc4[t_] = *(const LAS u32x2*)(lds + tlb + (16 * t_ + l15) * SQB + kq_ * 2); }
                }
            }
            f32x4 aC[4], alC, aR[4], alR, r0 = Z4, r1 = Z4;
            {
                const f32x4 X = MF(ONES, LF0, Z4);
                aC[0] = MF(M0, LF0, Z4); aC[1] = MF(M1, LF0, Z4); aC[2] = MF(M0, LF1, X); aC[3] = MF(M1, LF1, X); alC = MF(ONES, LF1, X);
                const f32x4 Y = MF(LF0, ONES, Z4);
                alR = MF(LF1, ONES, Y);
                if (FULL) { aR[0] = MF(LF0, M0, Z4); aR[1] = MF(LF0, M1, Z4); aR[2] = MF(LF1, M0, Y); aR[3] = MF(LF1, M1, Y); r0 = MF(LF0, SEL, Z4); r1 = MF(LF1, SEL, Y); }
            }
            bf16x8 KdA[2];
            {
                float kd[16];
#pragma unroll
                for (int tt = 0; tt < 4; ++tt)
#pragma unroll
                    for (int j = 0; j < 4; ++j) kd[4 * tt + j] = kcf[4 * tt + j] * __expf(alC[j] - aC[tt][j]);
                u32x4 p0, p1;
                p0.x = cvt_pk_bf16(kd[0], kd[1]); p0.y = cvt_pk_bf16(kd[2], kd[3]); p0.z = cvt_pk_bf16(kd[4], kd[5]); p0.w = cvt_pk_bf16(kd[6], kd[7]);
                p1.x = cvt_pk_bf16(kd[8], kd[9]); p1.y = cvt_pk_bf16(kd[10], kd[11]); p1.z = cvt_pk_bf16(kd[12], kd[13]); p1.w = cvt_pk_bf16(kd[14], kd[15]);
                KdA[0] = __builtin_bit_cast(bf16x8, p0); KdA[1] = __builtin_bit_cast(bf16x8, p1);
            }
            f32x4 dk;
#pragma unroll
            for (int j = 0; j < 4; ++j) dk[j] = __expf(alR[j]);
            sumal = sumal + alR;
            if (FULL) {
                f32x4 er0, er1, c10;
#pragma unroll
                for (int j = 0; j < 4; ++j) { er0[j] = __expf(r0[j]); er1[j] = __expf(r1[j]); c10[j] = __expf(r1[j] - r0[j]); }
#pragma unroll
                for (int tt = 0; tt < 4; ++tt) {
                    const f32x4 rI = (tt < 2) ? r0 : r1, erI = (tt < 2) ? er0 : er1;
                    const float qf[4] = {bflo(qc[tt].x), bfhi(qc[tt].x), bflo(qc[tt].y), bfhi(qc[tt].y)}, kf[4] = {1.0f - __expf(bflo(kc4[tt].x)), 1.0f - __expf(bfhi(kc4[tt].x)), 1.0f - __expf(bflo(kc4[tt].y)), 1.0f - __expf(bfhi(kc4[tt].y))};
                    float qd[4], qt[4], kt[4], k1[4];
#pragma unroll
                    for (int j = 0; j < 4; ++j) { const float d = fminf(fmaxf(aR[tt][j] - rI[j], -80.f), 80.f);
                        qt[j] = qf[j] * __expf(d); qd[j] = qt[j] * erI[j]; kt[j] = kf[j] * __expf(-d); k1[j] = kt[j] * c10[j]; }
                    const int off = (16 * tt + l15) * SQB + (16 * w + 4 * quad) * 2;
                    u32x2 wq, wt, wk;
                    wq.x = cvt_pk_bf16(qd[0], qd[1]); wq.y = cvt_pk_bf16(qd[2], qd[3]); wt.x = cvt_pk_bf16(qt[0], qt[1]); wt.y = cvt_pk_bf16(qt[2], qt[3]); wk.x = cvt_pk_bf16(kt[0], kt[1]); wk.y = cvt_pk_bf16(kt[2], kt[3]);
                    *(LAS u32x2*)(lds + L_QD + off) = wq;
                    *(LAS u32x2*)(lds + L_QT + off) = wt;
                    if (tt < 2) { u32x2 w1; w1.x = cvt_pk_bf16(k1[0], k1[1]); w1.y = cvt_pk_bf16(k1[2], k1[3]);
                        *(LAS u32x2*)(lds + L_KT0 + off) = wk; *(LAS u32x2*)(lds + L_KT1 + off) = w1; }
                    else *(LAS u32x2*)(lds + L_KT1 + off) = wk;
                }
                LBAR();
            }
            const int ti = w >> 1, vh = w & 1;
#pragma unroll
            for (int v2 = 0; v2 < 8; ++v2) {
#pragma unroll
                for (int j = 0; j < 4; ++j) Sacc[v2][j] *= dk[j];
#pragma unroll
                for (int ks = 0; ks < 2; ++ks) { const LAS unsigned char* vp = lds + vtb + (32 * ks + 4 * quad + (l15 >> 2)) * SVR + (16 * v2 + 4 * (l15 & 3)) * 2;
                    const u32x2 v0 = TRR(vp), v1 = TRR(vp + 16 * SVR); const u32x4 vb = (u32x4){v0.x, v0.y, v1.x, v1.y};
                    Sacc[v2] = MF(KdA[ks], __builtin_bit_cast(bf16x8, vb), Sacc[v2]); }
            }
            if (FULL) {
                bf16x8 pa[2];
                {
                    f32x4 pT[4];
                    const LAS unsigned char* KT = (ti < 2) ? (lds + L_KT0) : (lds + L_KT1);
                    bf16x8 qf[4];
#pragma unroll
                    for (int ks = 0; ks < 4; ++ks) qf[ks] = *(const LAS bf16x8*)(lds + L_QT + (16 * ti + l15) * SQB + (8 * quad + 32 * ks) * 2);
#pragma unroll
                    for (int sj = 0; sj < 4; ++sj) {
                        bf16x8 kf[4];
#pragma unroll
                        for (int ks = 0; ks < 4; ++ks) kf[ks] = *(const LAS bf16x8*)(KT + (16 * sj + l15) * SQB + (8 * quad + 32 * ks) * 2);
                        pT[sj] = Z4;
#pragma unroll
                        for (int ks = 0; ks < 4; ++ks) pT[sj] = MF(kf[ks], qf[ks], pT[sj]);
                    }
#pragma unroll
                    for (int sj = 0; sj < 4; ++sj)
#pragma unroll
                        for (int j = 0; j < 4; ++j) { const bool keep = (sj < ti) || (sj == ti && 4 * quad + j <= l15); pT[sj][j] = keep ? pT[sj][j] : 0.f; }
#pragma unroll
                    for (int pp = 0; pp < 2; ++pp) { u32x4 x; x.x = cvt_pk_bf16(pT[2 * pp][0], pT[2 * pp][1]); x.y = cvt_pk_bf16(pT[2 * pp][2], pT[2 * pp][3]);
                        x.z = cvt_pk_bf16(pT[2 * pp + 1][0], pT[2 * pp + 1][1]); x.w = cvt_pk_bf16(pT[2 * pp + 1][2], pT[2 * pp + 1][3]); pa[pp] = __builtin_bit_cast(bf16x8, x); }
                }
#pragma unroll 2
                for (int i = 0; i < 4; ++i) { const int vt = 4 * vh + i;
                    f32x4 o = Z4;
#pragma unroll
                    for (int ks = 0; ks < 4; ++ks) { const bf16x8 qdf = *(const LAS bf16x8*)(lds + L_QD + (16 * ti + l15) * SQB + (8 * quad + 32 * ks) * 2);
                        const bf16x8 bfr = *(const LAS bf16x8*)(lds + L_ST + (16 * vt + l15) * SQB + (8 * quad + 32 * ks) * 2); o = MF(qdf, bfr, o); }
#pragma unroll
                    for (int pp = 0; pp < 2; ++pp) { const LAS unsigned char* vp = lds + vtb + (32 * pp + 4 * quad + (l15 >> 2)) * SVR + (16 * vt + 4 * (l15 & 3)) * 2;
                        const u32x2 v0 = TRR(vp), v1 = TRR(vp + 16 * SVR); const u32x4 vb = (u32x4){v0.x, v0.y, v1.x, v1.y};
                        o = MF(pa[pp], __builtin_bit_cast(bf16x8, vb), o); }
                    bf16_t* op = (bf16_t*)Ob + (rowbase + (size_t)c * CH + 16 * ti + 4 * quad) * D + colq + 16 * vt + l15;
                    const unsigned o01 = cvt_pk_bf16(o[0], o[1]), o23 = cvt_pk_bf16(o[2], o[3]);
                    op[0] = (bf16_t)(o01 & 0xffffu); op[(size_t)D] = (bf16_t)(o01 >> 16); op[(size_t)2 * D] = (bf16_t)(o23 & 0xffffu); op[(size_t)3 * D] = (bf16_t)(o23 >> 16);
                }
            }
            if (FULL) LBAR();
            if (FULL) {
#pragma unroll
                for (int v2 = 0; v2 < 8; ++v2) { u32x2 sw; sw.x = cvt_pk_bf16(Sacc[v2][0], Sacc[v2][1]); sw.y = cvt_pk_bf16(Sacc[v2][2], Sacc[v2][3]);
                    *(LAS u32x2*)(lds + L_ST + (16 * v2 + l15) * SQB + (16 * w + 4 * quad) * 2) = sw; }
            }
            S2_STORE(vtn, tln);
        }
        if (!FULL) {
            float* sl = SLOC + (size_t)(bh * NSEG + seg) * 128 * 128;
#pragma unroll
            for (int vt = 0; vt < 8; ++vt)
#pragma unroll
                for (int j = 0; j < 4; ++j) sl[(16 * w + 4 * quad + j) * 128 + 16 * vt + l15] = Sacc[vt][j];
            if (l15 == 0) { f32x4 pv;
#pragma unroll
                for (int j = 0; j < 4; ++j) pv[j] = __expf(sumal[j]);
                *(f32x4*)(PLOC + (size_t)(bh * NSEG + seg) * 128 + 16 * w + 4 * quad) = pv; }
        } else if (g == 0 && seg == NSEG - 1) {
#pragma unroll
            for (int vt = 0; vt < 8; ++vt)
#pragma unroll
                for (int j = 0; j < 4; ++j) sb[(16 * w + 4 * quad + j) * 128 + 16 * vt + l15] = Sacc[vt][j];
        }
        __syncthreads();
#undef S2_LOAD
#undef S2_STORE
#undef S2_LF
    }
}
#undef TCOL
#undef TRR
}


#define XB_TMO      128
#define XB_XCNT(j)  (256  + 64 * (j))
#define XB_XSUB(j)  (1280 + 64 * (j))
#define XB_XGEN(j)  (2304 + 64 * (j))
#define XB_TOP      3328
#define XB_TOPGEN   3392
#define XCD_BAR_WORDS 3456
#define XB_SPIN_CAP (1u << 22)
__device__ __forceinline__ unsigned xb_ld(unsigned* p)              { return __hip_atomic_load(p, __ATOMIC_RELAXED, __HIP_MEMORY_SCOPE_AGENT); }
__device__ __forceinline__ unsigned xb_add(unsigned* p, unsigned v) { return __hip_atomic_fetch_add(p, v, __ATOMIC_RELAXED, __HIP_MEMORY_SCOPE_AGENT); }
__device__ __forceinline__ unsigned xb_xcc_id() { return (unsigned)__builtin_amdgcn_s_getreg((3 << 11) | 20) & 0xFu; }
#define XB_SPIN(cond, bar) do { unsigned _sp = 0; while (cond) { __builtin_amdgcn_s_sleep(1); \
    if ((++_sp & 255u) == 0u) { if (xb_ld(&(bar)[XB_TMO])) break; if (_sp > XB_SPIN_CAP) { atomicAdd(&(bar)[XB_TMO], 1u); break; } } } } while (0)
struct XcdBarrier { unsigned* bar; unsigned x; volatile LAS unsigned* st; };
__device__ __forceinline__ XcdBarrier xcd_barrier_post(unsigned* bar, volatile LAS unsigned* st) {
    XcdBarrier b; b.bar = bar; b.x = xb_xcc_id(); b.st = st;
    if (threadIdx.x == 0) (void)xb_add(&bar[XB_XCNT(b.x)], 1u);
    return b;
}
__device__ __forceinline__ void xcd_barrier_complete(unsigned* bar, unsigned x, unsigned& nloc, unsigned& nx) {
    const unsigned G = gridDim.x * gridDim.y * gridDim.z;
    unsigned sum, cnt, mine, sp = 0u;
    for (;;) {
        sum = 0u; cnt = 0u; mine = 0u;
#pragma unroll
        for (unsigned j = 0; j < 16; ++j) { const unsigned c = xb_ld(&bar[XB_XCNT(j)]); sum += c; cnt += (c > 0u) ? 1u : 0u; mine = (j == x) ? c : mine; }
        if (sum == G) break;
        __builtin_amdgcn_s_sleep(1);
        if ((++sp & 255u) == 0u) { if (xb_ld(&bar[XB_TMO])) break; if (sp > XB_SPIN_CAP) { atomicAdd(&bar[XB_TMO], 1u); break; } }
    }
    nloc = mine > 0u ? mine : 1u; nx = cnt > 0u ? cnt : 1u;
}
__device__ __forceinline__ void xcd_barrier(const XcdBarrier& b) {
    asm volatile("s_waitcnt vmcnt(0)" ::: "memory");
    __syncthreads();
    if (threadIdx.x == 0) {
        unsigned* bar = b.bar;
        __builtin_amdgcn_s_waitcnt(0);
        unsigned nloc = b.st[0], nx = b.st[1];
        if (nloc == 0u) { xcd_barrier_complete(bar, b.x, nloc, nx); b.st[0] = nloc; b.st[1] = nx; }
        const unsigned old = xb_add(&bar[XB_XSUB(b.x)], 1u);
        const unsigned gen = old / nloc;
        if (old + 1u == (gen + 1u) * nloc) {
            __builtin_amdgcn_fence(__ATOMIC_RELEASE, "agent");
            asm volatile("s_waitcnt vmcnt(0)" ::: "memory");
            const unsigned og = xb_add(&bar[XB_TOP], 1u);
            const unsigned tg = og / nx;
            if (og + 1u == (tg + 1u) * nx) xb_add(&bar[XB_TOPGEN], 1u);
            else XB_SPIN(xb_ld(&bar[XB_TOPGEN]) == tg, bar);
            __builtin_amdgcn_fence(__ATOMIC_ACQUIRE, "agent");
            xb_add(&bar[XB_XGEN(b.x)], 1u);
            asm volatile("s_waitcnt vmcnt(0)" ::: "memory");
        } else {
            XB_SPIN(xb_ld(&bar[XB_XGEN(b.x)]) == gen, bar);
            __builtin_amdgcn_fence(__ATOMIC_ACQUIRE, "agent");
            asm volatile("s_waitcnt vmcnt(0)" ::: "memory");
        }
    }
    __syncthreads();
}

__global__ void __launch_bounds__(NTHREADS, 2) fwd_megakernel(Args a) {
    extern __shared__ __attribute__((aligned(16))) unsigned char lds_raw[];
    LAS unsigned char* lds = (LAS unsigned char*)lds_raw;
    cg::grid_group grid = cg::this_grid();
    if (threadIdx.x < 16) ((LAS unsigned*)(lds + MISC_OFF))[threadIdx.x] = 0u;
    __syncthreads();
    const XcdBarrier xbar = xcd_barrier_post((unsigned*)(a.ws + WS_CTL), (volatile LAS unsigned*)(lds + MISC_OFF));
    grid.sync();
    for (int i = 0; i < 17; ++i) a.in[i] = as_global(a.in[i]);
    a.out = as_global(a.out); a.ws = as_global(a.ws);
    const float* ng = a.in[I_NG];
    float* out = a.out;
#define GSYNC() xcd_barrier(xbar)
#define WSP(off) (cx.ws + (off))
#define ADA ((const float*)WSP(WS_ADA))

    { const Ctx cx = mkctx(a.ws); p0_prologue(a, lds, cx); }
    GSYNC();
    { const Ctx cx = mkctx(a.ws); normmod_phase(a.in[I_X], ng + 0 * D, ADA, 0, 1, (bf16_t*)WSP(WS_H1), cx); }
    GSYNC();
    { const Ctx cx = mkctx(a.ws); pg8::Gemm g{(const bf16_t*)WSP(WS_H1), (const bf16_t*)WSP(WS_W1IN), M, 2 * FF, D}; pg8::StaticOrder S; S.init(M, 2 * FF, cx.G, cx.bid);
      pg8::EpiSwiGLU E{(bf16_t*)WSP(WS_ACT1), FF}; pg8::gemm_phase(lds, g, S, E, cx.tid); }
    GSYNC();
    { const Ctx cx = mkctx(a.ws); pg8::Gemm g{(const bf16_t*)WSP(WS_ACT1), (const bf16_t*)WSP(WS_W1OUT), M, D, FF}; pg8::StaticOrder S; S.init(M, D, cx.G, cx.bid);
      pg8::EpiStore E{(bf16_t*)WSP(WS_Y1), D}; pg8::gemm_phase(lds, g, S, E, cx.tid); }
    GSYNC();
    { const Ctx cx = mkctx(a.ws); res_phase<true, false, true, false, true>((const bf16_t*)WSP(WS_Y1), a.in[I_X], WSP(WS_XB), 0.5f, ADA, 2, ng + 1 * D, ng + 2 * D, 3, 4, (bf16_t*)WSP(WS_H2), cx); }
    GSYNC();
    for (int g = 0; g < NG; ++g) {
        { const Ctx cx = mkctx(a.ws); bf16_t* H2g = (bf16_t*)WSP(WS_H2) + (size_t)g * MG * D;
          pg8::Gemm gm{H2g, (const bf16_t*)WSP(WS_WMIX), MG, NMIX, D}; pg8::StaticOrder S; S.init(MG, NMIX, cx.G, cx.bid);
          pg8::EpiMix E{(bf16_t*)WSP(WS_CB), (bf16_t*)WSP(WS_P), (bf16_t*)WSP(WS_Q), (bf16_t*)WSP(WS_LF), (bf16_t*)WSP(WS_V), (bf16_t*)WSP(WS_GS), (bf16_t*)WSP(WS_SA), (bf16_t*)WSP(WS_SB),
                        (const float*)WSP(WS_LB), (bf16_t*)WSP(WS_KK)};
          pg8::gemm_phase(lds, gm, S, E, cx.tid); }
        GSYNC();
        { const Ctx cx = mkctx(a.ws); conv_phase((bf16_t*)WSP(WS_CB), (const bf16_t*)WSP(WS_P), (bf16_t*)WSP(WS_HALO), a.in[I_CONVW], a.in[I_CONVB], g, cx); }
        { const Ctx cx = mkctx(a.ws); float* sloc = (float*)((bf16_t*)WSP(WS_H2) + (size_t)g * MG * D);
          scan2::scan_pass<false>(lds, (const bf16_t*)WSP(WS_Q), (const bf16_t*)WSP(WS_LF), (const bf16_t*)WSP(WS_KK), (const bf16_t*)WSP(WS_V), (float*)WSP(WS_O), (float*)WSP(WS_SBUF), sloc, (float*)WSP(WS_PLOC), g, cx); }
        GSYNC();
        { const Ctx cx = mkctx(a.ws); float* sloc = (float*)((bf16_t*)WSP(WS_H2) + (size_t)g * MG * D);
          scan2::scan_pass<true>(lds, (const bf16_t*)WSP(WS_Q), (const bf16_t*)WSP(WS_LF), (const bf16_t*)WSP(WS_KK), (const bf16_t*)WSP(WS_V), (float*)WSP(WS_O), (float*)WSP(WS_SBUF), sloc, (float*)WSP(WS_PLOC), g, cx); }
        GSYNC();
        { const Ctx cx = mkctx(a.ws); og_phase((const float*)WSP(WS_O), (const bf16_t*)WSP(WS_GS), a.in[I_HGG], (bf16_t*)WSP(WS_Q), cx); }
        GSYNC();
        { const Ctx cx = mkctx(a.ws); pg8::Gemm gm{(const bf16_t*)WSP(WS_CB), (const bf16_t*)WSP(WS_WCO), MG, D, D}; pg8::StaticOrder S; S.init(MG, D, cx.G, cx.bid);
          pg8::EpiGate<0> E{(bf16_t*)WSP(WS_SA), (const bf16_t*)WSP(WS_SB)}; pg8::gemm_phase(lds, gm, S, E, cx.tid); }
        { const Ctx cx = mkctx(a.ws); pg8::Gemm gm{(const bf16_t*)WSP(WS_Q), (const bf16_t*)WSP(WS_WHO), MG, D, D}; pg8::StaticOrder S; S.init(MG, D, cx.G, cx.bid);
          pg8::EpiGate<1> E{(bf16_t*)WSP(WS_SA), (const bf16_t*)WSP(WS_SB)}; pg8::gemm_phase(lds, gm, S, E, cx.tid); }
        GSYNC();
        { const Ctx cx = mkctx(a.ws); bf16_t* H2g = (bf16_t*)WSP(WS_H2) + (size_t)g * MG * D;
          pg8::Gemm gm{(const bf16_t*)WSP(WS_SA), (const bf16_t*)WSP(WS_WMO), MG, D, D}; pg8::StaticOrder S; S.init(MG, D, cx.G, cx.bid);
          pg8::EpiStore E{H2g, D}; pg8::gemm_phase(lds, gm, S, E, cx.tid); }
        GSYNC();
    }
    { const Ctx cx = mkctx(a.ws); res_phase<true, true, false, true, true>((const bf16_t*)WSP(WS_H2), WSP(WS_XB), WSP(WS_XB), 1.0f, ADA, 5, ng + 3 * D, ng + 4 * D, 6, 7, (bf16_t*)WSP(WS_H3), cx); }
    GSYNC();
    { const Ctx cx = mkctx(a.ws); pg8::Gemm g{(const bf16_t*)WSP(WS_H3), (const bf16_t*)WSP(WS_W2IN), M, 2 * FF, D}; pg8::StaticOrder S; S.init(M, 2 * FF, cx.G, cx.bid);
      pg8::EpiSwiGLU E{(bf16_t*)WSP(WS_ACT2), FF}; pg8::gemm_phase(lds, g, S, E, cx.tid); }
    GSYNC();
    { const Ctx cx = mkctx(a.ws); pg8::Gemm g{(const bf16_t*)WSP(WS_ACT2), (const bf16_t*)WSP(WS_W2OUT), M, D, FF}; pg8::StaticOrder S; S.init(M, D, cx.G, cx.bid);
      pg8::EpiStore E{(bf16_t*)WSP(WS_Y2), D}; pg8::gemm_phase(lds, g, S, E, cx.tid); }
    GSYNC();
    { const Ctx cx = mkctx(a.ws); res_phase<false, false, false, true, false>((const bf16_t*)WSP(WS_Y2), WSP(WS_XB), out, 0.5f, ADA, 8, ng + 5 * D, nullptr, 0, 0, nullptr, cx); }
#undef GSYNC
}

extern "C" void kernel_launch(void* const* d_in, const int* in_sizes, int n_in, void* d_out, int out_size, void* d_ws, size_t ws_size, hipStream_t stream) {
    static int grid = 0;
    if (grid == 0) {
        if (n_in != 17 || in_sizes[0] != M * D || out_size != M * D || ws_size < WS_END) {
            fprintf(stderr, "kernel_launch: unexpected shapes (n_in %d, in0 %d, out %d, ws %zu)\n", n_in, n_in > 0 ? in_sizes[0] : -1, out_size, ws_size); grid = -1; return; }
        int dev = 0, cus = 0, per_cu = 0;
        if (hipGetDevice(&dev) != hipSuccess || hipDeviceGetAttribute(&cus, hipDeviceAttributeMultiprocessorCount, dev) != hipSuccess) { grid = -1; return; }
        if (hipFuncSetAttribute((const void*)fwd_megakernel, hipFuncAttributeMaxDynamicSharedMemorySize, LDS_BYTES) != hipSuccess) { fprintf(stderr, "kernel_launch: hipFuncSetAttribute failed\n"); grid = -1; return; }
        if (hipOccupancyMaxActiveBlocksPerMultiprocessor(&per_cu, (const void*)fwd_megakernel, NTHREADS, LDS_BYTES) != hipSuccess || per_cu < 1) { fprintf(stderr, "kernel_launch: occupancy query says %d\n", per_cu); per_cu = 1; }
        (void)hipGetLastError();
        grid = cus * 1;
        if (grid > 256) grid = 256;
    }
    if (grid < 0) return;
    if (hipMemsetAsync((char*)d_ws + WS_CTL, 0, CTL_BYTES, stream) != hipSuccess) { fprintf(stderr, "kernel_launch: memset failed\n"); return; }
    Args a{};
    for (int i = 0; i < 17; ++i) a.in[i] = (const float*)d_in[i];
    a.out = (float*)d_out; a.ws = (unsigned char*)d_ws;
    void* args[] = {&a};
    hipError_t e = hipLaunchCooperativeKernel((const void*)fwd_megakernel, dim3(grid), dim3(NTHREADS), args, LDS_BYTES, stream);
    if (e != hipSuccess) fprintf(stderr, "kernel_launch: cooperative launch failed: %s (grid %d)\n", hipGetErrorString(e), grid);
}
```

```cpp
#include <hip/hip_runtime.h>
#include <hip/hip_cooperative_groups.h>
#include <cstdio>
#include <cstdint>
namespace cg = cooperative_groups;

#define LAS __attribute__((address_space(3)))
#define GAS __attribute__((address_space(1)))
template <class T> __device__ __forceinline__ T* as_global(T* p) { unsigned long long u = (unsigned long long)p; asm volatile("" : "+s"(u)); return (T*)(GAS T*)u; }
typedef unsigned short bf16_t;
typedef short bf16x8 __attribute__((ext_vector_type(8)));
typedef short s16x4 __attribute__((ext_vector_type(4)));
typedef float f32x4 __attribute__((ext_vector_type(4)));
typedef float f32x2 __attribute__((ext_vector_type(2)));
typedef unsigned u32x4 __attribute__((ext_vector_type(4)));
typedef unsigned u32x2 __attribute__((ext_vector_type(2)));

constexpr int D = 1024, NB = 8, SEQ = 8192, M = NB * SEQ, FF = 2816, NMIX = 9216;
constexpr int NG = 2, SG = SEQ / NG, MG = NB * SG, CH = 64, NCH = SG / CH;
constexpr float EPS = 1e-6f;
constexpr int NTHREADS = 512, NWAVES = 8;

constexpr size_t MiB = 1u << 20;
constexpr size_t WS_ADA = 0;
constexpr size_t WS_LB = 320 * 1024;
constexpr size_t WS_HALO = 384 * 1024;
constexpr size_t WS_PLOC = 512 * 1024;
constexpr size_t WS_SBUF = 1 * MiB;
constexpr size_t WS_CTL = 5 * MiB, CTL_BYTES = 65536;
constexpr size_t WS_W1IN = 6 * MiB, WS_W1OUT = 17 * MiB, WS_WMIX = 23 * MiB, WS_WCO = 41 * MiB, WS_WHO = 43 * MiB, WS_WMO = 45 * MiB, WS_W2IN = 47 * MiB, WS_W2OUT = 58 * MiB;
constexpr size_t WS_H1 = 64 * MiB, WS_ACT1 = 192 * MiB, WS_Y1 = 544 * MiB;
constexpr size_t WS_H2 = 64 * MiB;
constexpr size_t WS_CB = 192 * MiB, WS_P = 256 * MiB, WS_Q = 320 * MiB, WS_LF = 384 * MiB, WS_V = 448 * MiB, WS_GS = 512 * MiB, WS_SA = 576 * MiB, WS_SB = 640 * MiB, WS_O = 704 * MiB, WS_KK = 832 * MiB;
constexpr size_t WS_XB = 896 * MiB;
constexpr size_t WS_H3 = 192 * MiB, WS_ACT2 = 320 * MiB, WS_Y2 = 672 * MiB;
constexpr size_t WS_END = 1024 * MiB;

constexpr int LDS_BYTES = 158 * 1024;
constexpr int MISC_OFF = LDS_BYTES - 64;

__device__ __forceinline__ float bf2f(unsigned b) { return __uint_as_float(b << 16); }
__device__ __forceinline__ float bflo(unsigned w) { return __uint_as_float(w << 16); }
__device__ __forceinline__ float bfhi(unsigned w) { return __uint_as_float(w & 0xffff0000u); }
typedef __bf16 bf16v2 __attribute__((ext_vector_type(2)));
__device__ __forceinline__ unsigned cvt_pk_bf16(float lo, float hi) { const f32x2 v = {lo, hi}; const bf16v2 r = __builtin_convertvector(v, bf16v2); return __builtin_bit_cast(unsigned, r); }
__device__ __forceinline__ float fsigmoid(float x) { return __builtin_amdgcn_rcpf(1.0f + __expf(-x)); }
__device__ __forceinline__ float fsilu(float x) { return x * fsigmoid(x); }
__device__ __forceinline__ float wave_sum(float v) {
#pragma unroll
    for (int o = 1; o < 64; o <<= 1) v += __shfl_xor(v, o);
    return v;
}

namespace pg8 {
constexpr int BM = 256, BK = 64, HALF = 128, HTB = HALF * BK * 2, STAGE_BYTES = 8 * HTB, NXCD = 8, WGM = 8;
__host__ __device__ __forceinline__ int lds_byte(int r, int c) { const int st = (r >> 4) * 2 + (c >> 5), rr = r & 15, cc = c & 31, ob = rr * 64 + cc * 2; return st * 1024 + (ob ^ (((ob >> 9) & 1) << 5)); }
__host__ __device__ __forceinline__ void stage_rc(int b, int& R, int& C) { const int st = b / 1024, sb = b % 1024, swz = sb ^ (((sb >> 9) & 1) << 5); R = (st >> 1) * 16 + swz / 64; C = (st & 1) * 32 + (swz % 64) / 2; }
__host__ __device__ __forceinline__ int perm32(int rho) { const int n = rho >> 4, i = rho & 15; return 8 * (i >> 2) + 4 * n + (i & 3); }

struct Unit { int pm, pn; };
struct Gemm { const bf16_t* A; const bf16_t* Bt; int M, N, K; };

struct StaticOrder {
    int nM, nN, nwg, G, c;
    __host__ __device__ void init(int M_, int N_, int G_, int c_) { nM = M_ / BM; nN = N_ / BM; nwg = nM * nN; G = G_; c = c_; }
    __host__ __device__ bool next(int i, Unit& u) const {
        const long L = (long)i * G + c; if (L >= nwg) return false;
        int wgid = (int)L; { const int q = nwg / NXCD, r = nwg % NXCD, xcd = wgid % NXCD, off = wgid / NXCD; wgid = (xcd < r ? xcd * (q + 1) : r * (q + 1) + (xcd - r) * q) + off; }
        const int nig = WGM * nN, gid = wgid / nig, fm = gid * WGM, gsz = (nM - fm) < WGM ? (nM - fm) : WGM;
        u.pm = fm + ((wgid % nig) % gsz); u.pn = (wgid % nig) / gsz; return true;
    }
};

template <class Epi>
__device__ __forceinline__ void gemm_phase(LAS unsigned char* lds, const Gemm g, const StaticOrder& S, const Epi& E, const int tid) {
    const int wid = __builtin_amdgcn_readfirstlane(tid >> 6), lane = tid & 63, wr = wid >> 2, wc = wid & 3, fr = lane & 15, fq = lane >> 4;
    const int K = g.K, nt = K / BK;
    unsigned voffA, voffB;
    { int R, C; stage_rc(tid * 16, R, C); const int Rb = ((R & ~31) + perm32(R & 31)); voffA = (unsigned)(R * K + C) * 2u; voffB = (unsigned)(Rb * K + C) * 2u; }
    const size_t pstep = (size_t)64 * K * 2;
    const size_t kstep = (size_t)(BK * 2);
    const size_t hstep = (size_t)HALF * K * 2;
    const size_t tstep = 2 * hstep;
    const unsigned ldsw = (unsigned)wid * 1024u;
    const int aoff = lds_byte(wr * 64 + fr, fq * 8), boff = lds_byte(wc * 32 + fr, fq * 8);
#define PG8_SA(b, h) (((b) * 2 + (h)) * HTB)
#define PG8_SB(b, h) ((4 + (b) * 2 + (h)) * HTB)
#define PG8_STAGE(bufoff, gbase, voff) do { _Pragma("unroll") for (int _i = 0; _i < 2; ++_i) \
        __builtin_amdgcn_global_load_lds((const unsigned*)((const char*)(gbase) + _i * pstep + (voff)), (LAS unsigned*)(lds + (bufoff) + ldsw + _i * 8192), 16, 0, 0); } while (0)
#define PG8_LDA(dst, b, h) do { _Pragma("unroll") for (int m = 0; m < 4; ++m) _Pragma("unroll") for (int k = 0; k < 2; ++k) dst[m][k] = *(const LAS bf16x8*)(lds + PG8_SA(b, h) + aoff + m * 2048 + k * 1024); } while (0)
#define PG8_LDB(dst, b, h) do { _Pragma("unroll") for (int n = 0; n < 2; ++n) _Pragma("unroll") for (int k = 0; k < 2; ++k) dst[n][k] = *(const LAS bf16x8*)(lds + PG8_SB(b, h) + boff + n * 2048 + k * 1024); } while (0)
#define PG8_MMA(ai, bj, At, Bt) do { __builtin_amdgcn_s_setprio(1); _Pragma("unroll") for (int m = 0; m < 4; ++m) _Pragma("unroll") for (int n = 0; n < 2; ++n) _Pragma("unroll") for (int k = 0; k < 2; ++k) \
        acc[ai][bj][m][n] = __builtin_amdgcn_mfma_f32_16x16x32_bf16(Bt[n][k], At[m][k], acc[ai][bj][m][n], 0, 0, 0); __builtin_amdgcn_s_setprio(0); } while (0)
#define PG8_WAIT_V(n) asm volatile("s_waitcnt vmcnt(" #n ")" ::: "memory")
#define PG8_WAIT_L(n) asm volatile("s_waitcnt lgkmcnt(" #n ")" ::: "memory")
#define PG8_BAR __builtin_amdgcn_s_barrier()
#define PG8_SCHED __builtin_amdgcn_sched_barrier(0)
    Unit cur, nxt; int ui = 0;
    if (!S.next(0, cur)) return;
    f32x4 acc[2][2][4][2];
#pragma unroll
    for (int a = 0; a < 2; ++a)
#pragma unroll
        for (int b = 0; b < 2; ++b)
#pragma unroll
            for (int m = 0; m < 4; ++m)
#pragma unroll
                for (int n = 0; n < 2; ++n) acc[a][b][m][n] = (f32x4){0.f, 0.f, 0.f, 0.f};
    bf16x8 At[4][2], B0[2][2], B1[2][2];
    const char* cA = (const char*)g.A + (size_t)cur.pm * tstep; const char* cB = (const char*)g.Bt + (size_t)cur.pn * tstep;
    PG8_STAGE(PG8_SB(0, 0), cB, voffB); PG8_STAGE(PG8_SB(0, 1), cB + hstep, voffB); PG8_STAGE(PG8_SA(0, 0), cA, voffA); PG8_STAGE(PG8_SA(0, 1), cA + hstep, voffA);
    if (wr == 1) PG8_BAR;
    PG8_WAIT_V(2); PG8_BAR;
    PG8_STAGE(PG8_SB(1, 0), cB + kstep, voffB); PG8_STAGE(PG8_SA(1, 0), cA + kstep, voffA); PG8_STAGE(PG8_SB(1, 1), cB + hstep + kstep, voffB);
    if constexpr (Epi::RELAX) PG8_WAIT_V(0); else PG8_WAIT_V(6);
    PG8_BAR;
    for (;;) {
        const bool has_next = S.next(ui + 1, nxt);
        const char* nA = has_next ? (const char*)g.A + (size_t)nxt.pm * tstep : cA; const char* nB = has_next ? (const char*)g.Bt + (size_t)nxt.pn * tstep : cB;
#define PG8_KBODY(t, W1, W2, LASTOK) do { \
            const bool last = (LASTOK) && ((t) == nt - 2); \
            const char* a1 = cA + (size_t)((t) + 1) * kstep; \
            const char* a2 = last ? nA : cA + (size_t)((t) + 2) * kstep; const char* b2 = last ? nB : cB + (size_t)((t) + 2) * kstep; \
            const char* a3 = a2 + kstep; const char* b3 = b2 + kstep; \
            PG8_LDB(B0, 0, 0); PG8_LDB(B1, 0, 1); PG8_SCHED; PG8_LDA(At, 0, 0); PG8_STAGE(PG8_SA(1, 1), a1 + hstep, voffA); \
            W1; PG8_WAIT_L(0); PG8_BAR; PG8_MMA(0, 0, At, B0); PG8_MMA(0, 1, At, B1); PG8_BAR; PG8_SCHED; \
            PG8_LDA(At, 0, 1); PG8_STAGE(PG8_SB(0, 0), b2, voffB); PG8_STAGE(PG8_SB(0, 1), b2 + hstep, voffB); PG8_STAGE(PG8_SA(0, 0), a2, voffA); \
            W2; PG8_WAIT_L(0); PG8_BAR; PG8_MMA(1, 0, At, B0); PG8_MMA(1, 1, At, B1); PG8_BAR; PG8_SCHED; \
            PG8_LDB(B0, 1, 0); PG8_LDB(B1, 1, 1); PG8_SCHED; PG8_LDA(At, 1, 0); PG8_STAGE(PG8_SA(0, 1), a2 + hstep, voffA); \
            PG8_WAIT_V(8); PG8_WAIT_L(0); PG8_BAR; PG8_MMA(0, 0, At, B0); PG8_MMA(0, 1, At, B1); PG8_BAR; PG8_SCHED; \
            PG8_LDA(At, 1, 1); PG8_STAGE(PG8_SB(1, 0), b3, voffB); PG8_STAGE(PG8_SB(1, 1), b3 + hstep, voffB); PG8_STAGE(PG8_SA(1, 0), a3, voffA); \
            PG8_WAIT_V(8); PG8_WAIT_L(0); PG8_BAR; PG8_MMA(1, 0, At, B0); PG8_MMA(1, 1, At, B1); PG8_BAR; PG8_SCHED; } while (0)
        if constexpr (Epi::RELAX) {
            if constexpr (Epi::NS_MIN >= 16) PG8_KBODY(0, PG8_WAIT_V(24), PG8_WAIT_V(24), false); else PG8_KBODY(0, PG8_WAIT_V(16), PG8_WAIT_V(16), false);
            for (int t = 2; t < nt; t += 2) PG8_KBODY(t, PG8_WAIT_V(8), PG8_WAIT_V(8), true);
        } else {
            for (int t = 0; t < nt; t += 2) PG8_KBODY(t, PG8_WAIT_V(8), PG8_WAIT_V(8), true);
        }
#undef PG8_KBODY
        if (wr == 0) PG8_BAR;
        { int tl_ = tid; asm volatile("" : "+v"(tl_)); E(acc, cur, wr, wc, tl_ & 15, (tl_ & 63) >> 4); }
        if (!has_next) break;
#pragma unroll
        for (int a = 0; a < 2; ++a)
#pragma unroll
            for (int b = 0; b < 2; ++b)
#pragma unroll
                for (int m = 0; m < 4; ++m)
#pragma unroll
                    for (int n = 0; n < 2; ++n) acc[a][b][m][n] = (f32x4){0.f, 0.f, 0.f, 0.f};
        cur = nxt; cA = nA; cB = nB; ++ui;
        if (wr == 1) PG8_BAR;
    }
    PG8_WAIT_V(0);
    PG8_BAR;
#undef PG8_SA
#undef PG8_SB
#undef PG8_STAGE
#undef PG8_LDA
#undef PG8_LDB
#undef PG8_MMA
#undef PG8_WAIT_V
#undef PG8_WAIT_L
#undef PG8_BAR
#undef PG8_SCHED
}

typedef f32x4 AccT[2][2][4][2];

struct EpiStore {
    static constexpr int NS_MIN = 16; static constexpr bool RELAX = false;
    bf16_t* O; int ldc;
    __device__ __forceinline__ void operator()(const AccT& acc, const Unit& u, int wr, int wc, int fr, int fq) const {
        const int row0 = u.pm * BM + wr * 64 + fr, col0 = u.pn * BM + wc * 32 + 8 * fq;
#pragma unroll
        for (int ai = 0; ai < 2; ++ai)
#pragma unroll
            for (int m = 0; m < 4; ++m) { bf16_t* rowp = O + (size_t)(row0 + ai * HALF + m * 16) * ldc + col0;
#pragma unroll
                for (int bj = 0; bj < 2; ++bj) { const f32x4 v0 = acc[ai][bj][m][0], v1 = acc[ai][bj][m][1];
                    u32x4 w; w.x = cvt_pk_bf16(v0[0], v0[1]); w.y = cvt_pk_bf16(v0[2], v0[3]); w.z = cvt_pk_bf16(v1[0], v1[1]); w.w = cvt_pk_bf16(v1[2], v1[3]);
                    __builtin_nontemporal_store(w, (u32x4*)(rowp + bj * HALF)); } }
    }
};
struct EpiSwiGLU {
    static constexpr int NS_MIN = 8; static constexpr bool RELAX = true;
    bf16_t* O; int ldc;
    __device__ __forceinline__ void operator()(const AccT& acc, const Unit& u, int wr, int wc, int fr, int fq) const {
        const int row0 = u.pm * BM + wr * 64 + fr, col0 = u.pn * HALF + wc * 32 + 8 * fq;
#pragma unroll
        for (int ai = 0; ai < 2; ++ai)
#pragma unroll
            for (int m = 0; m < 4; ++m) { bf16_t* rowp = O + (size_t)(row0 + ai * HALF + m * 16) * ldc + col0;
                float r[8];
#pragma unroll
                for (int n = 0; n < 2; ++n)
#pragma unroll
                    for (int j = 0; j < 4; ++j) { const float a = acc[ai][0][m][n][j], b = acc[ai][1][m][n][j]; r[n * 4 + j] = fsilu(a) * b; }
                u32x4 w; w.x = cvt_pk_bf16(r[0], r[1]); w.y = cvt_pk_bf16(r[2], r[3]); w.z = cvt_pk_bf16(r[4], r[5]); w.w = cvt_pk_bf16(r[6], r[7]);
                __builtin_nontemporal_store(w, (u32x4*)rowp); }
    }
};
template <int MODE> struct EpiGate {
    static constexpr int NS_MIN = 16; static constexpr bool RELAX = false;
    bf16_t* SA; const bf16_t* SB;
    __device__ __forceinline__ void operator()(const AccT& acc, const Unit& u, int wr, int wc, int fr, int fq) const {
        const int row0 = u.pm * BM + wr * 64 + fr, col0 = u.pn * BM + wc * 32 + 8 * fq;
#pragma unroll
        for (int ai = 0; ai < 2; ++ai)
#pragma unroll
            for (int m = 0; m < 4; ++m) { const size_t off = (size_t)(row0 + ai * HALF + m * 16) * D + col0;
#pragma unroll
                for (int bj = 0; bj < 2; ++bj) { const f32x4 v0 = acc[ai][bj][m][0], v1 = acc[ai][bj][m][1];
                    const u32x4 s = *(const u32x4*)(SA + off + bj * HALF);
                    float r[8];
                    if (MODE == 0) {
                        r[0] = bflo(s.x) * v0[0]; r[1] = bfhi(s.x) * v0[1]; r[2] = bflo(s.y) * v0[2]; r[3] = bfhi(s.y) * v0[3];
                        r[4] = bflo(s.z) * v1[0]; r[5] = bfhi(s.z) * v1[1]; r[6] = bflo(s.w) * v1[2]; r[7] = bfhi(s.w) * v1[3];
                    } else {
                        const u32x4 t = *(const u32x4*)(SB + off + bj * HALF);
                        r[0] = bflo(s.x) + bflo(t.x) * v0[0]; r[1] = bfhi(s.x) + bfhi(t.x) * v0[1]; r[2] = bflo(s.y) + bflo(t.y) * v0[2]; r[3] = bfhi(s.y) + bfhi(t.y) * v0[3];
                        r[4] = bflo(s.z) + bflo(t.z) * v1[0]; r[5] = bfhi(s.z) + bfhi(t.z) * v1[1]; r[6] = bflo(s.w) + bflo(t.w) * v1[2]; r[7] = bfhi(s.w) + bfhi(t.w) * v1[3];
                    }
                    u32x4 w; w.x = cvt_pk_bf16(r[0], r[1]); w.y = cvt_pk_bf16(r[2], r[3]); w.z = cvt_pk_bf16(r[4], r[5]); w.w = cvt_pk_bf16(r[6], r[7]);
                    *(u32x4*)(SA + off + bj * HALF) = w; } }
    }
};
struct EpiMix {
    static constexpr int NS_MIN = 8; static constexpr bool RELAX = false;
    bf16_t *CB, *P, *Q, *LF, *V, *GS, *SA, *SB; const float* lb; bf16_t* KK;
    template <int TYPE>
    __device__ __forceinline__ void tile(bf16_t* O, const AccT& acc, int row0, int colbase) const {
#pragma unroll
        for (int bj = 0; bj < 2; ++bj) { const int col = colbase + bj * HALF;
            float lbv[8];
            if (TYPE == 3) { const f32x4 l0 = *(const f32x4*)(lb + col), l1 = *(const f32x4*)(lb + col + 4);
#pragma unroll
                for (int j = 0; j < 4; ++j) { lbv[j] = l0[j]; lbv[4 + j] = l1[j]; } }
#pragma unroll
            for (int ai = 0; ai < 2; ++ai)
#pragma unroll
                for (int m = 0; m < 4; ++m) { float r[8];
#pragma unroll
                    for (int n = 0; n < 2; ++n)
#pragma unroll
                        for (int j = 0; j < 4; ++j) { const float x = acc[ai][bj][m][n][j]; float y;
                            if (TYPE == 0) y = x; else if (TYPE == 1) y = fsilu(x); else if (TYPE == 2) y = fsigmoid(x);
                            else { const float l = lbv[n * 4 + j], sg = fsigmoid(x); y = __logf(l + (1.0f - l) * sg); }
                            r[n * 4 + j] = y; }
                    u32x4 w; w.x = cvt_pk_bf16(r[0], r[1]); w.y = cvt_pk_bf16(r[2], r[3]); w.z = cvt_pk_bf16(r[4], r[5]); w.w = cvt_pk_bf16(r[6], r[7]);
                    __builtin_nontemporal_store(w, (u32x4*)(O + (size_t)(row0 + ai * HALF + m * 16) * D + col)); } }
    }
    __device__ __forceinline__ void operator()(const AccT& acc, const Unit& u, int wr, int wc, int fr, int fq) const {
        const int row0 = u.pm * BM + wr * 64 + fr, pn = u.pn;
        if (pn >= 4 && pn < 12) {
            const int col0 = (pn - 4) * HALF + wc * 32 + 8 * fq;
#pragma unroll
            for (int ai = 0; ai < 2; ++ai)
#pragma unroll
                for (int m = 0; m < 4; ++m) { float r[8];
#pragma unroll
                    for (int n = 0; n < 2; ++n)
#pragma unroll
                        for (int j = 0; j < 4; ++j) r[n * 4 + j] = acc[ai][0][m][n][j] * acc[ai][1][m][n][j];
                    u32x4 w; w.x = cvt_pk_bf16(r[0], r[1]); w.y = cvt_pk_bf16(r[2], r[3]); w.z = cvt_pk_bf16(r[4], r[5]); w.w = cvt_pk_bf16(r[6], r[7]);
                    __builtin_nontemporal_store(w, (u32x4*)(P + (size_t)(row0 + ai * HALF + m * 16) * D + col0)); }
            return;
        }
        const int colbase = (pn & 3) * BM + wc * 32 + 8 * fq;
        if (pn < 4) tile<0>(CB, acc, row0, colbase);
        else if (pn < 16) tile<1>(Q, acc, row0, colbase);
        else if (pn < 20) tile<3>(LF, acc, row0, colbase);
        else if (pn < 24) tile<0>(V, acc, row0, colbase);
        else if (pn < 28) tile<1>(GS, acc, row0, colbase);
        else if (pn < 32) tile<2>(SA, acc, row0, colbase);
        else tile<2>(SB, acc, row0, colbase);
    }
};
}

struct Args { const float* in[17]; float* out; unsigned char* ws; };
enum { I_X = 0, I_C, I_WADA, I_BADA, I_NG, I_W1IN, I_W1OUT, I_WMIX, I_CONVW, I_CONVB, I_WCO, I_HGG, I_LBL, I_WHO, I_WMO, I_W2IN, I_W2OUT };

struct Ctx { int tid, lane, wave, G, bid; unsigned char* ws; };
__device__ __forceinline__ Ctx mkctx(unsigned char* ws_in) {
    Ctx c; int t = threadIdx.x; asm volatile("" : "+v"(t)); c.tid = t; c.lane = t & 63; c.wave = __builtin_amdgcn_readfirstlane(t >> 6);
    int g = gridDim.x; asm volatile("" : "+s"(g)); c.G = g; int b = blockIdx.x; asm volatile("" : "+s"(b)); c.bid = b;
    unsigned char* w = ws_in; asm volatile("" : "+s"(w)); c.ws = as_global(w); return c;
}

__device__ __forceinline__ int map_row(int mode, int n0) {
    if (mode == 1) { const int half = n0 >= FF ? 1 : 0; const int j = n0 - half * FF; return (j >> 7) * 256 + half * 128 + (j & 127); }
    if (mode == 2) { const int s = n0 >> 10, j = n0 & 1023; if (s == 1 || s == 2) return (4 + (j >> 7)) * 256 + (s - 1) * 128 + (j & 127); return n0; }
    return n0;
}
__device__ __forceinline__ void p0_transpose_item(const float* W, int K, int N, bf16_t* WT, int mode, LAS float* scr, int item, int lane) {
    const int nblk = N / 32, kb = item / nblk, nb = item % nblk, k0 = 64 * kb, n0 = 32 * nb;
    const int drow = map_row(mode, n0);
    float wv[32];
#pragma unroll
    for (int i = 0; i < 32; ++i) wv[i] = W[(size_t)(k0 + 2 * i + (lane >> 5)) * N + n0 + (lane & 31)];
#pragma unroll
    for (int i = 0; i < 32; ++i) scr[(2 * i + (lane >> 5)) * 33 + (lane & 31)] = wv[i];
    asm volatile("s_waitcnt lgkmcnt(0)" ::: "memory");
    const int c = lane & 7;
#pragma unroll
    for (int j = 0; j < 4; ++j) { const int n = (lane >> 3) + 8 * j; const LAS float* s = scr + (8 * c) * 33 + n;
        u32x4 o; o.x = cvt_pk_bf16(s[0 * 33], s[1 * 33]); o.y = cvt_pk_bf16(s[2 * 33], s[3 * 33]); o.z = cvt_pk_bf16(s[4 * 33], s[5 * 33]); o.w = cvt_pk_bf16(s[6 * 33], s[7 * 33]);
        *(u32x4*)(WT + (size_t)(drow + n) * K + k0 + 8 * c) = o; }
    asm volatile("s_waitcnt lgkmcnt(0)" ::: "memory");
}

__device__ __forceinline__ void p0_prologue(const Args& a, LAS unsigned char* lds, const Ctx& cx) {
    unsigned char* ws = cx.ws;
    const int G = cx.G, tid = cx.tid, wave = cx.wave, lane = cx.lane, bid = cx.bid;
    {
        LAS float* sc = (LAS float*)lds;
        LAS float* red = (LAS float*)(lds + 32768);
        for (int i = tid; i < NB * D; i += NTHREADS) sc[i] = fsilu(a.in[I_C][i]);
        __syncthreads();
        const float* wada = a.in[I_WADA];
        float* ada = (float*)(ws + WS_ADA);
        for (int nb = bid; nb < 9 * D / 64; nb += G) {
            const int n = nb * 64 + lane, k0 = wave * 128;
            float acc[8];
#pragma unroll
            for (int b = 0; b < 8; ++b) acc[b] = 0.f;
#pragma unroll 16
            for (int kk = 0; kk < 128; ++kk) { const float wv = wada[(size_t)(k0 + kk) * (9 * D) + n];
#pragma unroll
                for (int b = 0; b < 8; ++b) acc[b] += sc[b * D + k0 + kk] * wv; }
#pragma unroll
            for (int b = 0; b < 8; ++b) red[(wave * 8 + b) * 64 + lane] = acc[b];
            __syncthreads();
            { const int b = tid >> 6; float s = 0.f;
#pragma unroll
              for (int w = 0; w < 8; ++w) s += red[(w * 8 + b) * 64 + lane];
              ada[b * (9 * D) + n] = s + a.in[I_BADA][n]; }
            __syncthreads();
        }
    }
    if (bid == G - 1) {
        float* lbo = (float*)(ws + WS_LB); const float* ll = a.in[I_LBL];
        for (int c = tid; c < D; c += NTHREADS) lbo[c] = 1.0f / (1.0f + expf(ll[D + c] - ll[c]));
    }
    __syncthreads();
    LAS float* scr = (LAS float*)(lds + 49152 + wave * 8704);
    const int gw = bid * NWAVES + wave, NGW = G * NWAVES;
    constexpr int I_FI = (D / 64) * (2 * FF / 32), I_FO = (FF / 64) * (D / 32), I_MI = (D / 64) * (NMIX / 32), I_SQ = (D / 64) * (D / 32);
    constexpr int NITEMS = 2 * I_FI + 2 * I_FO + I_MI + 3 * I_SQ;
    for (int it = gw; it < NITEMS; it += NGW) {
        int r = it;
        if (r < I_MI) { p0_transpose_item(a.in[I_WMIX], D, NMIX, (bf16_t*)(ws + WS_WMIX), 2, scr, r, lane); continue; } r -= I_MI;
        if (r < I_FI) { p0_transpose_item(a.in[I_W1IN], D, 2 * FF, (bf16_t*)(ws + WS_W1IN), 1, scr, r, lane); continue; } r -= I_FI;
        if (r < I_FI) { p0_transpose_item(a.in[I_W2IN], D, 2 * FF, (bf16_t*)(ws + WS_W2IN), 1, scr, r, lane); continue; } r -= I_FI;
        if (r < I_FO) { p0_transpose_item(a.in[I_W1OUT], FF, D, (bf16_t*)(ws + WS_W1OUT), 0, scr, r, lane); continue; } r -= I_FO;
        if (r < I_FO) { p0_transpose_item(a.in[I_W2OUT], FF, D, (bf16_t*)(ws + WS_W2OUT), 0, scr, r, lane); continue; } r -= I_FO;
        if (r < I_SQ) { p0_transpose_item(a.in[I_WCO], D, D, (bf16_t*)(ws + WS_WCO), 0, scr, r, lane); continue; } r -= I_SQ;
        if (r < I_SQ) { p0_transpose_item(a.in[I_WHO], D, D, (bf16_t*)(ws + WS_WHO), 0, scr, r, lane); continue; } r -= I_SQ;
        p0_transpose_item(a.in[I_WMO], D, D, (bf16_t*)(ws + WS_WMO), 0, scr, r, lane);
    }
}

__device__ __forceinline__ int gm_row(int m) { return ((m >> 12) & 1) * MG + (m >> 13) * SG + (m & (SG - 1)); }

__device__ __forceinline__ void normmod_phase(const float* x, const float* ng, const float* ada, int shslot, int scslot, bf16_t* H, const Ctx& cx) {
    const int wave = cx.wave, lane = cx.lane; const int gw = cx.bid * NWAVES + wave, NGW = cx.G * NWAVES;
    constexpr int RB = 4;
    for (int m4 = gw; m4 < M / RB; m4 += NGW) {
        const int m0 = m4 * RB, b = m0 >> 13;
        f32x4 v[RB][4];
#pragma unroll
        for (int r = 0; r < RB; ++r) { const f32x4* xr = (const f32x4*)(x + (size_t)(m0 + r) * D) + lane;
#pragma unroll
            for (int j = 0; j < 4; ++j) v[r][j] = xr[64 * j]; }
        float rstd[RB];
#pragma unroll
        for (int r = 0; r < RB; ++r) { float s = 0.f;
#pragma unroll
            for (int j = 0; j < 4; ++j) s += (v[r][j].x * v[r][j].x + v[r][j].y * v[r][j].y) + (v[r][j].z * v[r][j].z + v[r][j].w * v[r][j].w);
            rstd[r] = rsqrtf(wave_sum(s) * (1.f / D) + EPS); }
        const float* sh = ada + (size_t)b * 9 * D + shslot * D; const float* sc = ada + (size_t)b * 9 * D + scslot * D;
#pragma unroll
        for (int j = 0; j < 4; ++j) { const int c = 4 * lane + 256 * j;
            const f32x4 gv = *(const f32x4*)(ng + c), scv = *(const f32x4*)(sc + c), shv = *(const f32x4*)(sh + c);
            const f32x4 mul = gv * (scv + 1.0f);
#pragma unroll
            for (int r = 0; r < RB; ++r) { const f32x4 h = v[r][j] * rstd[r] * mul + shv;
                u32x2 w; w.x = cvt_pk_bf16(h.x, h.y); w.y = cvt_pk_bf16(h.z, h.w); ((u32x2*)(H + (size_t)(m0 + r) * D) + lane)[64 * j] = w; } }
    }
}

template <bool HAS_NEXT, bool Y_GM, bool H_GM, bool XIN_BF, bool XOUT_BF>
__device__ __forceinline__ void res_phase(const bf16_t* Y, const void* xin_, void* xout_, float wres, const float* ada, int gslot, const float* ng_post,
                                          const float* ng_pre, int shslot, int scslot, bf16_t* H, const Ctx& cx) {
    const int wave = cx.wave, lane = cx.lane; const int gw = cx.bid * NWAVES + wave, NGW = cx.G * NWAVES;
    constexpr int RB = XIN_BF ? 4 : 2;
    for (int m4 = gw; m4 < M / RB; m4 += NGW) {
        const int m0 = m4 * RB, b = m0 >> 13;
        const size_t y0 = Y_GM ? (size_t)gm_row(m0) : (size_t)m0;
        u32x2 yw[RB][4]; f32x4 xv[RB][4];
#pragma unroll
        for (int r = 0; r < RB; ++r) { const u32x2* yr = (const u32x2*)(Y + (y0 + r) * D) + lane;
#pragma unroll
            for (int j = 0; j < 4; ++j) { yw[r][j] = yr[64 * j];
                if (XIN_BF) { const u32x2 xw = ((const u32x2*)((const bf16_t*)xin_ + (size_t)(m0 + r) * D) + lane)[64 * j]; xv[r][j] = (f32x4){bflo(xw.x), bfhi(xw.x), bflo(xw.y), bfhi(xw.y)}; }
                else xv[r][j] = ((const f32x4*)((const float*)xin_ + (size_t)(m0 + r) * D) + lane)[64 * j]; } }
        float rstd[RB];
#pragma unroll
        for (int r = 0; r < RB; ++r) { float s = 0.f;
#pragma unroll
            for (int j = 0; j < 4; ++j) { const f32x4 y = (f32x4){bflo(yw[r][j].x), bfhi(yw[r][j].x), bflo(yw[r][j].y), bfhi(yw[r][j].y)}; s += (y.x * y.x + y.y * y.y) + (y.z * y.z + y.w * y.w); }
            rstd[r] = rsqrtf(wave_sum(s) * (1.f / D) + EPS) * wres; }
        const float* gp = ada + (size_t)b * 9 * D + gslot * D;
        float s2[RB];
#pragma unroll
        for (int r = 0; r < RB; ++r) s2[r] = 0.f;
#pragma unroll
        for (int j = 0; j < 4; ++j) { const int c = 4 * lane + 256 * j;
            const f32x4 gn = *(const f32x4*)(gp + c) * *(const f32x4*)(ng_post + c);
#pragma unroll
            for (int r = 0; r < RB; ++r) { const f32x4 y = (f32x4){bflo(yw[r][j].x), bfhi(yw[r][j].x), bflo(yw[r][j].y), bfhi(yw[r][j].y)};
                const f32x4 xn = xv[r][j] + gn * (y * rstd[r]); xv[r][j] = xn;
                if (XOUT_BF) { u32x2 xw; xw.x = cvt_pk_bf16(xn.x, xn.y); xw.y = cvt_pk_bf16(xn.z, xn.w); ((u32x2*)((bf16_t*)xout_ + (size_t)(m0 + r) * D) + lane)[64 * j] = xw; }
                else ((f32x4*)((float*)xout_ + (size_t)(m0 + r) * D) + lane)[64 * j] = xn;
                s2[r] += (xn.x * xn.x + xn.y * xn.y) + (xn.z * xn.z + xn.w * xn.w); } }
        if (HAS_NEXT) {
            float rstd2[RB];
#pragma unroll
            for (int r = 0; r < RB; ++r) rstd2[r] = rsqrtf(wave_sum(s2[r]) * (1.f / D) + EPS);
            const float* sh = ada + (size_t)b * 9 * D + shslot * D; const float* sc = ada + (size_t)b * 9 * D + scslot * D;
            const size_t h0 = H_GM ? (size_t)gm_row(m0) : (size_t)m0;
#pragma unroll
            for (int j = 0; j < 4; ++j) { const int c = 4 * lane + 256 * j;
                const f32x4 gv = *(const f32x4*)(ng_pre + c), scv = *(const f32x4*)(sc + c), shv = *(const f32x4*)(sh + c);
                const f32x4 mul = gv * (scv + 1.0f);
#pragma unroll
                for (int r = 0; r < RB; ++r) { const f32x4 h = xv[r][j] * rstd2[r] * mul + shv;
                    u32x2 w; w.x = cvt_pk_bf16(h.x, h.y); w.y = cvt_pk_bf16(h.z, h.w); ((u32x2*)(H + (h0 + r) * D) + lane)[64 * j] = w; } }
        }
    }
}

__device__ __forceinline__ void conv_phase(bf16_t* CB, const bf16_t* P, bf16_t* HALO, const float* cw, const float* cbias, int g, const Ctx& cx) {
    const int wave = cx.wave, lane = cx.lane; const int gw = cx.bid * NWAVES + wave, NGW = cx.G * NWAVES;
    constexpr int RB = 4;
    for (int r4 = gw; r4 < MG / RB; r4 += NGW) {
        const int r0 = r4 * RB, b = r0 >> 12, t0 = r0 & (SG - 1);
        u32x4 cb[RB][2], p[RB + 2][2];
#pragma unroll
        for (int j = 0; j < 2; ++j) { const int c = 8 * lane + 512 * j;
#pragma unroll
            for (int r = 0; r < RB; ++r) { cb[r][j] = *(const u32x4*)(CB + (size_t)(r0 + r) * D + c); p[r + 2][j] = *(const u32x4*)(P + (size_t)(r0 + r) * D + c); }
            if (t0 >= 2) { p[0][j] = *(const u32x4*)(P + (size_t)(r0 - 2) * D + c); p[1][j] = *(const u32x4*)(P + (size_t)(r0 - 1) * D + c); }
            else if (g > 0) { p[0][j] = *(const u32x4*)(HALO + (size_t)(b * 2 + 0) * D + c); p[1][j] = *(const u32x4*)(HALO + (size_t)(b * 2 + 1) * D + c); }
            else { p[0][j] = (u32x4){0u, 0u, 0u, 0u}; p[1][j] = (u32x4){0u, 0u, 0u, 0u}; } }
        if (g == 0 && t0 == SG - RB) {
#pragma unroll
            for (int j = 0; j < 2; ++j) { const int c = 8 * lane + 512 * j;
                *(u32x4*)(HALO + (size_t)(b * 2 + 0) * D + c) = p[RB][j]; *(u32x4*)(HALO + (size_t)(b * 2 + 1) * D + c) = p[RB + 1][j]; } }
#pragma unroll
        for (int j = 0; j < 2; ++j) { const int c = 8 * lane + 512 * j;
            float w0[8], w1[8], w2[8], bs[8];
#pragma unroll
            for (int h = 0; h < 2; ++h) { const f32x4 a0 = *(const f32x4*)(cw + c + 4 * h), a1 = *(const f32x4*)(cw + D + c + 4 * h), a2 = *(const f32x4*)(cw + 2 * D + c + 4 * h), bb = *(const f32x4*)(cbias + c + 4 * h);
#pragma unroll
                for (int e = 0; e < 4; ++e) { w0[4 * h + e] = a0[e]; w1[4 * h + e] = a1[e]; w2[4 * h + e] = a2[e]; bs[4 * h + e] = bb[e]; } }
#pragma unroll
            for (int r = 0; r < RB; ++r) {
                const unsigned cbw[4] = {cb[r][j].x, cb[r][j].y, cb[r][j].z, cb[r][j].w}, p0w[4] = {p[r + 2][j].x, p[r + 2][j].y, p[r + 2][j].z, p[r + 2][j].w},
                               p1w[4] = {p[r + 1][j].x, p[r + 1][j].y, p[r + 1][j].z, p[r + 1][j].w}, p2w[4] = {p[r][j].x, p[r][j].y, p[r][j].z, p[r][j].w};
                float r8[8];
#pragma unroll
                for (int e = 0; e < 4; ++e) {
                    r8[2 * e] = bflo(cbw[e]) * (w0[2 * e] * bflo(p2w[e]) + w1[2 * e] * bflo(p1w[e]) + w2[2 * e] * bflo(p0w[e]) + bs[2 * e]);
                    r8[2 * e + 1] = bfhi(cbw[e]) * (w0[2 * e + 1] * bfhi(p2w[e]) + w1[2 * e + 1] * bfhi(p1w[e]) + w2[2 * e + 1] * bfhi(p0w[e]) + bs[2 * e + 1]);
                }
                u32x4 w; w.x = cvt_pk_bf16(r8[0], r8[1]); w.y = cvt_pk_bf16(r8[2], r8[3]); w.z = cvt_pk_bf16(r8[4], r8[5]); w.w = cvt_pk_bf16(r8[6], r8[7]);
                *(u32x4*)(CB + (size_t)(r0 + r) * D + c) = w; } }
    }
}

__device__ __forceinline__ void og_phase(const float* O, const bf16_t* GS, const float* gain, bf16_t* OG, const Ctx& cx) {
    const int wave = cx.wave, lane = cx.lane; const int gw = cx.bid * NWAVES + wave, NGW = cx.G * NWAVES;
    constexpr int RB = 4;
    const int c = 16 * lane;
    for (int r4 = gw; r4 < MG / RB; r4 += NGW) {
        const int r0 = r4 * RB;
        f32x4 o[RB][4]; u32x4 gsv[RB][2]; u32x4 ow_[RB][2];
#pragma unroll
        for (int r = 0; r < RB; ++r) { const bf16_t* op = (const bf16_t*)O + (size_t)(r0 + r) * D + c;
            ow_[r][0] = *(const u32x4*)op; ow_[r][1] = *(const u32x4*)(op + 8);
            gsv[r][0] = *(const u32x4*)(GS + (size_t)(r0 + r) * D + c); gsv[r][1] = *(const u32x4*)(GS + (size_t)(r0 + r) * D + c + 8); }
        f32x4 gn[4];
#pragma unroll
        for (int j = 0; j < 4; ++j) gn[j] = *(const f32x4*)(gain + c + 4 * j);
#pragma unroll
        for (int r = 0; r < RB; ++r) { float s = 0.f;
            { const unsigned w8[8] = {ow_[r][0].x, ow_[r][0].y, ow_[r][0].z, ow_[r][0].w, ow_[r][1].x, ow_[r][1].y, ow_[r][1].z, ow_[r][1].w};
#pragma unroll
              for (int j = 0; j < 4; ++j) o[r][j] = (f32x4){bflo(w8[2 * j]), bfhi(w8[2 * j]), bflo(w8[2 * j + 1]), bfhi(w8[2 * j + 1])}; }
#pragma unroll
            for (int j = 0; j < 4; ++j) s += (o[r][j].x * o[r][j].x + o[r][j].y * o[r][j].y) + (o[r][j].z * o[r][j].z + o[r][j].w * o[r][j].w);
            s += __shfl_xor(s, 1); s += __shfl_xor(s, 2); s += __shfl_xor(s, 4);
            const float rstd = rsqrtf(s * (1.f / 128.f) + EPS);
            const unsigned gw4[8] = {gsv[r][0].x, gsv[r][0].y, gsv[r][0].z, gsv[r][0].w, gsv[r][1].x, gsv[r][1].y, gsv[r][1].z, gsv[r][1].w};
            unsigned ow[8];
#pragma unroll
            for (int j = 0; j < 4; ++j) {
                const float a0 = o[r][j].x * rstd * gn[j].x * bflo(gw4[2 * j]), a1 = o[r][j].y * rstd * gn[j].y * bfhi(gw4[2 * j]);
                const float a2 = o[r][j].z * rstd * gn[j].z * bflo(gw4[2 * j + 1]), a3 = o[r][j].w * rstd * gn[j].w * bfhi(gw4[2 * j + 1]);
                ow[2 * j] = cvt_pk_bf16(a0, a1); ow[2 * j + 1] = cvt_pk_bf16(a2, a3); }
            *(u32x4*)(OG + (size_t)(r0 + r) * D + c) = (u32x4){ow[0], ow[1], ow[2], ow[3]};
            *(u32x4*)(OG + (size_t)(r0 + r) * D + c + 8) = (u32x4){ow[4], ow[5], ow[6], ow[7]}; }
    }
}

namespace scan {
constexpr int SQB = 272;
constexpr int SVB = 144;
constexpr int L_QD = 0, L_QT = L_QD + 64 * SQB, L_KT0 = L_QT + 64 * SQB, L_KT1 = L_KT0 + 32 * SQB, L_ST = L_KT1 + 64 * SQB, L_VT = L_ST + 2 * 32 * SQB,
              L_TQ = L_VT + 2 * 32 * SVB, L_TK = L_TQ + 64 * SQB, L_TL = L_TK + 64 * SQB, L_END = L_TL + 64 * SQB;
static_assert(L_END <= MISC_OFF, "scan LDS map");
#define LBAR() do { asm volatile("s_waitcnt lgkmcnt(0)" ::: "memory"); __builtin_amdgcn_s_barrier(); asm volatile("" ::: "memory"); } while (0)
#define MF(a, b, c) __builtin_amdgcn_mfma_f32_16x16x32_bf16((a), (b), (c), 0, 0, 0)

__device__ __forceinline__ void scan_phase(LAS unsigned char* lds, const bf16_t* Qb, const bf16_t* LFb, const bf16_t* KKb, const bf16_t* Vb, float* Ob, float* SBUF, int g, const Ctx& cx) {
    const int tid = cx.tid, w = cx.wave, lane = cx.lane;
    const int l15 = lane & 15, quad = lane >> 4;
    const f32x4 Z4 = (f32x4){0.f, 0.f, 0.f, 0.f};
    for (int unit = cx.bid; unit < 256; unit += cx.G) {
        const int xcd = unit & 7, jj0 = unit >> 3, vs = jj0 & 3, bh = xcd * 8 + (jj0 >> 2), b = bh >> 3, h = bh & 7;
        const size_t rowbase = (size_t)b * SG;
        const int colq = h * 128, colv = h * 128 + vs * 32;
        const int kc = colq + 16 * w + l15;
        const int kr = colq + 16 * w + 4 * quad;
        bf16x8 ONES, M0, M1, SEL;
#pragma unroll
        for (int j = 0; j < 8; ++j) { ONES[j] = (short)0x3F80; M0[j] = (8 * quad + j <= l15) ? (short)0x3F80 : (short)0; M1[j] = (8 * quad + j <= 16 + l15) ? (short)0x3F80 : (short)0; SEL[j] = (quad < 2) ? (short)0x3F80 : (short)0; }
        f32x4 Sacc[2];
        float* sb = SBUF + (size_t)bh * 128 * 128;
#pragma unroll
        for (int vt = 0; vt < 2; ++vt)
#pragma unroll
            for (int j = 0; j < 4; ++j) Sacc[vt][j] = (g == 0) ? 0.f : sb[(16 * w + 4 * quad + j) * 128 + vs * 32 + 16 * vt + l15];
#pragma unroll
        for (int vt = 0; vt < 2; ++vt) { u32x2 sw; sw.x = cvt_pk_bf16(Sacc[vt][0], Sacc[vt][1]); sw.y = cvt_pk_bf16(Sacc[vt][2], Sacc[vt][3]);
            *(LAS u32x2*)(lds + L_ST + (16 * vt + l15) * SQB + (16 * w + 4 * quad) * 2) = sw; }
        u32x4 rq[2], rk[2], rl[2]; u32x2 rv;
        const int vrow = tid >> 3, vvc = tid & 7;
        const int prow0 = tid >> 4, pkc = tid & 15;
        const int pp0 = ((pkc + 2 * (prow0 >> 3)) & 15) * 16, pp1 = ((pkc + 2 * ((prow0 + 32) >> 3)) & 15) * 16;
#define SC_LOAD(c) do { const size_t r0_ = rowbase + (size_t)(c) * CH; \
            rq[0] = *(const u32x4*)(Qb + (r0_ + prow0) * D + colq + 8 * pkc); rq[1] = *(const u32x4*)(Qb + (r0_ + prow0 + 32) * D + colq + 8 * pkc); \
            rk[0] = *(const u32x4*)(KKb + (r0_ + prow0) * D + colq + 8 * pkc); rk[1] = *(const u32x4*)(KKb + (r0_ + prow0 + 32) * D + colq + 8 * pkc); \
            rl[0] = *(const u32x4*)(LFb + (r0_ + prow0) * D + colq + 8 * pkc); rl[1] = *(const u32x4*)(LFb + (r0_ + prow0 + 32) * D + colq + 8 * pkc); \
            rv = *(const u32x2*)(Vb + (r0_ + vrow) * D + colv + 4 * vvc); } while (0)
#define SC_STOREV(c) do { LAS unsigned char* vt_ = lds + L_VT + ((c) & 1) * 32 * SVB + vrow * 2; \
            *(LAS unsigned short*)(vt_ + (4 * vvc + 0) * SVB) = (unsigned short)(rv.x & 0xffffu); *(LAS unsigned short*)(vt_ + (4 * vvc + 1) * SVB) = (unsigned short)(rv.x >> 16); \
            *(LAS unsigned short*)(vt_ + (4 * vvc + 2) * SVB) = (unsigned short)(rv.y & 0xffffu); *(LAS unsigned short*)(vt_ + (4 * vvc + 3) * SVB) = (unsigned short)(rv.y >> 16); \
            *(LAS u32x4*)(lds + L_TQ + prow0 * SQB + pp0) = rq[0]; *(LAS u32x4*)(lds + L_TQ + (prow0 + 32) * SQB + pp1) = rq[1]; \
            *(LAS u32x4*)(lds + L_TK + prow0 * SQB + pp0) = rk[0]; *(LAS u32x4*)(lds + L_TK + (prow0 + 32) * SQB + pp1) = rk[1]; \
            *(LAS u32x4*)(lds + L_TL + prow0 * SQB + pp0) = rl[0]; *(LAS u32x4*)(lds + L_TL + (prow0 + 32) * SQB + pp1) = rl[1]; } while (0)
        bf16x8 LF0, LF1; float kcf[16]; u32x2 qc[4], kc4[4];
#define TCOL(r_, kk_) (((kk_) + 16 * ((r_) >> 3)) & 127)
#define SC_CONSUME() do { const int kl_ = 16 * w + l15, kq_ = 16 * w + 4 * quad; \
            const LAS unsigned short* tl_ = (const LAS unsigned short*)(lds + L_TL); const LAS unsigned short* tk_ = (const LAS unsigned short*)(lds + L_TK); \
            unsigned short l_[16]; \
            _Pragma("unroll") for (int j_ = 0; j_ < 8; ++j_) { l_[j_] = tl_[(8 * quad + j_) * (SQB / 2) + TCOL(8 * quad, kl_)]; l_[8 + j_] = tl_[(32 + 8 * quad + j_) * (SQB / 2) + TCOL(32 + 8 * quad, kl_)]; } \
            _Pragma("unroll") for (int t_ = 0; t_ < 4; ++t_) { _Pragma("unroll") for (int j_ = 0; j_ < 4; ++j_) kcf[4 * t_ + j_] = bf2f((unsigned)tk_[(16 * t_ + 4 * quad + j_) * (SQB / 2) + TCOL(16 * t_ + 4 * quad, kl_)]); \
                qc[t_] = *(const LAS u32x2*)(lds + L_TQ + (16 * t_ + l15) * SQB + TCOL(16 * t_ + l15, kq_) * 2); kc4[t_] = *(const LAS u32x2*)(lds + L_TK + (16 * t_ + l15) * SQB + TCOL(16 * t_ + l15, kq_) * 2); } \
            u32x4 a_, b_; \
            a_.x = (unsigned)l_[0] | ((unsigned)l_[1] << 16); a_.y = (unsigned)l_[2] | ((unsigned)l_[3] << 16); a_.z = (unsigned)l_[4] | ((unsigned)l_[5] << 16); a_.w = (unsigned)l_[6] | ((unsigned)l_[7] << 16); \
            b_.x = (unsigned)l_[8] | ((unsigned)l_[9] << 16); b_.y = (unsigned)l_[10] | ((unsigned)l_[11] << 16); b_.z = (unsigned)l_[12] | ((unsigned)l_[13] << 16); b_.w = (unsigned)l_[14] | ((unsigned)l_[15] << 16); \
            LF0 = __builtin_bit_cast(bf16x8, a_); LF1 = __builtin_bit_cast(bf16x8, b_); } while (0)
        SC_LOAD(0); SC_STOREV(0);
        f32x4 oprev = Z4;
        for (int c = 0; c < NCH; ++c) {
            LBAR();
            { const int cn = (c + 1 < NCH) ? c + 1 : NCH - 1; SC_LOAD(cn); }
            asm volatile("" ::: "memory");
            {
                const int cp = c > 0 ? c - 1 : 0;
                float* op = Ob + (rowbase + (size_t)cp * CH + 16 * (w >> 1) + 4 * quad) * D + colv + 16 * (w & 1) + l15;
#pragma unroll
                for (int j = 0; j < 4; ++j) op[(size_t)j * D] = oprev[j];
            }
            asm volatile("" ::: "memory");
            SC_CONSUME();
            f32x4 aC[4], aR[4], alC, alR, r0, r1;
            {
                const f32x4 X = MF(ONES, LF0, Z4);
                aC[0] = MF(M0, LF0, Z4); aC[1] = MF(M1, LF0, Z4); aC[2] = MF(M0, LF1, X); aC[3] = MF(M1, LF1, X); alC = MF(ONES, LF1, X);
                const f32x4 Y = MF(LF0, ONES, Z4);
                aR[0] = MF(LF0, M0, Z4); aR[1] = MF(LF0, M1, Z4); aR[2] = MF(LF1, M0, Y); aR[3] = MF(LF1, M1, Y); alR = MF(LF1, ONES, Y);
                r0 = MF(LF0, SEL, Z4); r1 = MF(LF1, SEL, Y);
            }
            bf16x8 KdA[2];
            {
                float kd[16];
#pragma unroll
                for (int tt = 0; tt < 4; ++tt)
#pragma unroll
                    for (int j = 0; j < 4; ++j) kd[4 * tt + j] = kcf[4 * tt + j] * __expf(alC[j] - aC[tt][j]);
                u32x4 p0, p1;
                p0.x = cvt_pk_bf16(kd[0], kd[1]); p0.y = cvt_pk_bf16(kd[2], kd[3]); p0.z = cvt_pk_bf16(kd[4], kd[5]); p0.w = cvt_pk_bf16(kd[6], kd[7]);
                p1.x = cvt_pk_bf16(kd[8], kd[9]); p1.y = cvt_pk_bf16(kd[10], kd[11]); p1.z = cvt_pk_bf16(kd[12], kd[13]); p1.w = cvt_pk_bf16(kd[14], kd[15]);
                KdA[0] = __builtin_bit_cast(bf16x8, p0); KdA[1] = __builtin_bit_cast(bf16x8, p1);
            }
            f32x4 dk;
            {
                f32x4 er0, er1, c10;
#pragma unroll
                for (int j = 0; j < 4; ++j) { er0[j] = __expf(r0[j]); er1[j] = __expf(r1[j]); c10[j] = __expf(r1[j] - r0[j]); dk[j] = __expf(alR[j]); }
#pragma unroll
                for (int tt = 0; tt < 4; ++tt) {
                    const f32x4 rI = (tt < 2) ? r0 : r1, erI = (tt < 2) ? er0 : er1;
                    const float qf[4] = {bflo(qc[tt].x), bfhi(qc[tt].x), bflo(qc[tt].y), bfhi(qc[tt].y)}, kf[4] = {bflo(kc4[tt].x), bfhi(kc4[tt].x), bflo(kc4[tt].y), bfhi(kc4[tt].y)};
                    float qd[4], qt[4], kt[4], k1[4];
#pragma unroll
                    for (int j = 0; j < 4; ++j) { const float d = fminf(fmaxf(aR[tt][j] - rI[j], -80.f), 80.f);
                        qt[j] = qf[j] * __expf(d); qd[j] = qt[j] * erI[j]; kt[j] = kf[j] * __expf(-d); k1[j] = kt[j] * c10[j]; }
                    const int off = (16 * tt + l15) * SQB + (16 * w + 4 * quad) * 2;
                    u32x2 wq, wt, wk;
                    wq.x = cvt_pk_bf16(qd[0], qd[1]); wq.y = cvt_pk_bf16(qd[2], qd[3]); wt.x = cvt_pk_bf16(qt[0], qt[1]); wt.y = cvt_pk_bf16(qt[2], qt[3]); wk.x = cvt_pk_bf16(kt[0], kt[1]); wk.y = cvt_pk_bf16(kt[2], kt[3]);
                    *(LAS u32x2*)(lds + L_QD + off) = wq;
                    *(LAS u32x2*)(lds + L_QT + off) = wt;
                    if (tt < 2) { u32x2 w1; w1.x = cvt_pk_bf16(k1[0], k1[1]); w1.y = cvt_pk_bf16(k1[2], k1[3]);
                        *(LAS u32x2*)(lds + L_KT0 + off) = wk; *(LAS u32x2*)(lds + L_KT1 + off) = w1; }
                    else *(LAS u32x2*)(lds + L_KT1 + off) = wk;
                }
            }
            LBAR();
            f32x4 o = Z4;
            const int ti = w >> 1, vt = w & 1;
            {
                const LAS unsigned char* STc = lds + L_ST + (c & 1) * 32 * SQB;
                LAS unsigned char* STn = lds + L_ST + ((c + 1) & 1) * 32 * SQB;
                const LAS unsigned char* VTc = lds + L_VT + (c & 1) * 32 * SVB;
#pragma unroll
                for (int ks = 0; ks < 4; ++ks) {
                    const bf16x8 af = *(const LAS bf16x8*)(lds + L_QD + (16 * ti + l15) * SQB + (8 * quad + 32 * ks) * 2);
                    const bf16x8 bfr = *(const LAS bf16x8*)(STc + (16 * vt + l15) * SQB + (8 * quad + 32 * ks) * 2);
                    o = MF(af, bfr, o);
                }
                f32x4 pT[4];
                const LAS unsigned char* KT = (ti < 2) ? (lds + L_KT0) : (lds + L_KT1);
                bf16x8 qf[4];
#pragma unroll
                for (int ks = 0; ks < 4; ++ks) qf[ks] = *(const LAS bf16x8*)(lds + L_QT + (16 * ti + l15) * SQB + (8 * quad + 32 * ks) * 2);
#pragma unroll
                for (int sj = 0; sj < 4; ++sj) {
                    bf16x8 kf[4];
#pragma unroll
                    for (int ks = 0; ks < 4; ++ks) kf[ks] = *(const LAS bf16x8*)(KT + (16 * sj + l15) * SQB + (8 * quad + 32 * ks) * 2);
                    pT[sj] = Z4;
#pragma unroll
                    for (int ks = 0; ks < 4; ++ks) pT[sj] = MF(kf[ks], qf[ks], pT[sj]);
                }
#pragma unroll
                for (int sj = 0; sj < 4; ++sj)
#pragma unroll
                    for (int j = 0; j < 4; ++j) { const bool keep = (sj < ti) || (sj == ti && 4 * quad + j <= l15); pT[sj][j] = keep ? pT[sj][j] : 0.f; }
#pragma unroll
                for (int pp = 0; pp < 2; ++pp) {
                    u32x4 pa; pa.x = cvt_pk_bf16(pT[2 * pp][0], pT[2 * pp][1]); pa.y = cvt_pk_bf16(pT[2 * pp][2], pT[2 * pp][3]);
                    pa.z = cvt_pk_bf16(pT[2 * pp + 1][0], pT[2 * pp + 1][1]); pa.w = cvt_pk_bf16(pT[2 * pp + 1][2], pT[2 * pp + 1][3]);
                    const LAS unsigned char* vp = VTc + (16 * vt + l15) * SVB + (32 * pp + 4 * quad) * 2;
                    const u32x2 v0 = *(const LAS u32x2*)vp, v1 = *(const LAS u32x2*)(vp + 32);
                    const u32x4 vb = (u32x4){v0.x, v0.y, v1.x, v1.y};
                    o = MF(__builtin_bit_cast(bf16x8, pa), __builtin_bit_cast(bf16x8, vb), o);
                }
#pragma unroll
                for (int v2 = 0; v2 < 2; ++v2) {
#pragma unroll
                    for (int j = 0; j < 4; ++j) Sacc[v2][j] *= dk[j];
#pragma unroll
                    for (int ks = 0; ks < 2; ++ks) {
                        const LAS unsigned char* vp = VTc + (16 * v2 + l15) * SVB + (32 * ks + 4 * quad) * 2;
                        const u32x2 v0 = *(const LAS u32x2*)vp, v1 = *(const LAS u32x2*)(vp + 32);
                        const u32x4 vb = (u32x4){v0.x, v0.y, v1.x, v1.y};
                        Sacc[v2] = MF(KdA[ks], __builtin_bit_cast(bf16x8, vb), Sacc[v2]);
                    }
                    u32x2 sw; sw.x = cvt_pk_bf16(Sacc[v2][0], Sacc[v2][1]); sw.y = cvt_pk_bf16(Sacc[v2][2], Sacc[v2][3]);
                    *(LAS u32x2*)(STn + (16 * v2 + l15) * SQB + (16 * w + 4 * quad) * 2) = sw;
                }
            }
            SC_STOREV(c + 1);
            oprev = o;
        }
        {
            float* op = Ob + (rowbase + (size_t)(NCH - 1) * CH + 16 * (w >> 1) + 4 * quad) * D + colv + 16 * (w & 1) + l15;
#pragma unroll
            for (int j = 0; j < 4; ++j) op[(size_t)j * D] = oprev[j];
        }
        if (g == 0) {
#pragma unroll
            for (int vt = 0; vt < 2; ++vt)
#pragma unroll
                for (int j = 0; j < 4; ++j) sb[(16 * w + 4 * quad + j) * 128 + vs * 32 + 16 * vt + l15] = Sacc[vt][j];
        }
        __syncthreads();
#undef SC_LOAD
#undef SC_STOREV
#undef SC_CONSUME
#undef TCOL
    }
}
}

namespace scan2 {
constexpr int SQB = 272, SVR = 288, NSEG = 4, CPS = NCH / NSEG;
constexpr int L_QD = 0, L_QT = L_QD + 64 * SQB, L_KT0 = L_QT + 64 * SQB, L_KT1 = L_KT0 + 32 * SQB, L_ST = L_KT1 + 64 * SQB, L_VT = L_ST + 128 * SQB,
              L_TQ = L_VT + 64 * SVR, L_TL = L_TQ + 64 * SQB, L_END = L_TL + 64 * SQB;
static_assert(L_END <= MISC_OFF, "scan2 LDS map");
#define LBAR() do { asm volatile("s_waitcnt lgkmcnt(0)" ::: "memory"); __builtin_amdgcn_s_barrier(); asm volatile("" ::: "memory"); } while (0)
#define MF(a, b, c) __builtin_amdgcn_mfma_f32_16x16x32_bf16((a), (b), (c), 0, 0, 0)
#define TCOL(r_, kk_) (((kk_) + 16 * ((r_) >> 3)) & 127)
#define TRR(p_) __builtin_bit_cast(u32x2, __builtin_amdgcn_ds_read_tr16_b64_v4i16((LAS s16x4*)(p_)))

template <bool FULL>
__device__ __forceinline__ void scan_pass(LAS unsigned char* lds, const bf16_t* Qb, const bf16_t* LFb, const bf16_t* KKb, const bf16_t* Vb, float* Ob, float* SBUF, float* SLOC, float* PLOC, int g, const Ctx& cx) {
    const int tid = cx.tid, w = cx.wave, lane = cx.lane;
    const int l15 = lane & 15, quad = lane >> 4;
    const f32x4 Z4 = (f32x4){0.f, 0.f, 0.f, 0.f};
    for (int unit = cx.bid; unit < 256; unit += cx.G) {
        const int xcd = unit & 7, jj0 = unit >> 3, seg = jj0 & 3, bh = xcd * 8 + (jj0 >> 2), b = bh >> 3, h = bh & 7;
        const size_t rowbase = (size_t)b * SG + (size_t)seg * CPS * CH;
        const int colq = h * 128;
        const int kc = colq + 16 * w + l15;
        bf16x8 ONES, M0, M1, SEL;
#pragma unroll
        for (int j = 0; j < 8; ++j) { ONES[j] = (short)0x3F80; M0[j] = (8 * quad + j <= l15) ? (short)0x3F80 : (short)0; M1[j] = (8 * quad + j <= 16 + l15) ? (short)0x3F80 : (short)0; SEL[j] = (quad < 2) ? (short)0x3F80 : (short)0; }
        f32x4 Sacc[8];
        f32x4 sumal = Z4;
        float* sb = SBUF + (size_t)bh * 128 * 128;
        if (FULL) {
#pragma unroll
            for (int vt = 0; vt < 8; ++vt)
#pragma unroll
                for (int j = 0; j < 4; ++j) Sacc[vt][j] = (g == 0) ? 0.f : sb[(16 * w + 4 * quad + j) * 128 + 16 * vt + l15];
            for (int sp = 0; sp < seg; ++sp) {
                const float* sl = SLOC + (size_t)(bh * NSEG + sp) * 128 * 128; const float* pl = PLOC + (size_t)(bh * NSEG + sp) * 128;
                const f32x4 pv = *(const f32x4*)(pl + 16 * w + 4 * quad);
#pragma unroll
                for (int vt = 0; vt < 8; ++vt)
#pragma unroll
                    for (int j = 0; j < 4; ++j) Sacc[vt][j] = pv[j] * Sacc[vt][j] + sl[(16 * w + 4 * quad + j) * 128 + 16 * vt + l15];
            }
#pragma unroll
            for (int vt = 0; vt < 8; ++vt) { u32x2 sw; sw.x = cvt_pk_bf16(Sacc[vt][0], Sacc[vt][1]); sw.y = cvt_pk_bf16(Sacc[vt][2], Sacc[vt][3]);
                *(LAS u32x2*)(lds + L_ST + (16 * vt + l15) * SQB + (16 * w + 4 * quad) * 2) = sw; }
        } else {
#pragma unroll
            for (int vt = 0; vt < 8; ++vt) Sacc[vt] = Z4;
        }
        u32x4 rq[2], rvv[2], rl[2];
#define S2_LOAD(c) do { const size_t r0_ = rowbase + (size_t)(c) * CH; int t2_ = tid; asm volatile("" : "+v"(t2_)); \
            const unsigned toff = (unsigned)((t2_ >> 4) * D + colq + 8 * (t2_ & 15)); \
            const bf16_t* qb_ = Qb + r0_ * D; const bf16_t* vb_ = Vb + r0_ * D; const bf16_t* lb_ = LFb + r0_ * D; \
            if (FULL) { rq[0] = *(const u32x4*)(qb_ + toff); rq[1] = *(const u32x4*)(qb_ + 32 * D + toff); } \
            rvv[0] = *(const u32x4*)(vb_ + toff); rvv[1] = *(const u32x4*)(vb_ + 32 * D + toff); \
            rl[0] = *(const u32x4*)(lb_ + toff); rl[1] = *(const u32x4*)(lb_ + 32 * D + toff); } while (0)
#define S2_STORE(VB_, TB_) do { int t3_ = tid; asm volatile("" : "+v"(t3_)); const int prow0 = t3_ >> 4, pkc = t3_ & 15; \
            const int pp0 = ((pkc + 2 * (prow0 >> 3)) & 15) * 16, pp1 = ((pkc + 2 * ((prow0 + 32) >> 3)) & 15) * 16; \
            *(LAS u32x4*)(lds + (VB_) + prow0 * SVR + pkc * 16) = rvv[0]; *(LAS u32x4*)(lds + (VB_) + (prow0 + 32) * SVR + pkc * 16) = rvv[1]; \
            if (FULL) { *(LAS u32x4*)(lds + L_TQ + prow0 * SQB + pp0) = rq[0]; *(LAS u32x4*)(lds + L_TQ + (prow0 + 32) * SQB + pp1) = rq[1]; } \
            *(LAS u32x4*)(lds + (TB_) + prow0 * SQB + pkc * 16) = rl[0]; *(LAS u32x4*)(lds + (TB_) + (prow0 + 32) * SQB + pkc * 16) = rl[1]; } while (0)
        S2_LOAD(0); S2_STORE(L_VT, L_TL);
        bf16x8 LF0, LF1;
#define S2_LF(TB_) do { const LAS unsigned char* tp_ = lds + (TB_) + (8 * quad + (l15 >> 2)) * SQB + (16 * w + 4 * (l15 & 3)) * 2; \
            const u32x2 x0_ = TRR(tp_), x1_ = TRR(tp_ + 4 * SQB), x2_ = TRR(tp_ + 32 * SQB), x3_ = TRR(tp_ + 36 * SQB); \
            LF0 = __builtin_bit_cast(bf16x8, (u32x4){x0_.x, x0_.y, x1_.x, x1_.y}); LF1 = __builtin_bit_cast(bf16x8, (u32x4){x2_.x, x2_.y, x3_.x, x3_.y}); } while (0)
        const int l15o = l15, quado = quad;
        for (int c = 0; c < CPS; ++c) {
            int l15 = l15o, quad = quado; asm volatile("" : "+v"(l15), "+v"(quad));
            const int vtb = (!FULL && (c & 1)) ? L_QD : L_VT, tlb = (!FULL && (c & 1)) ? (L_QD + 64 * SVR) : L_TL;
            const int vtn = (!FULL && !(c & 1)) ? L_QD : L_VT, tln = (!FULL && !(c & 1)) ? (L_QD + 64 * SVR) : L_TL;
            LBAR();
            { const int cn = (c + 1 < CPS) ? c + 1 : CPS - 1; S2_LOAD(cn); }
            S2_LF(tlb);
            float kcf[16]; u32x2 qc[4], kc4[4];
            {
                const int kl_ = 16 * w + l15, kq_ = 16 * w + 4 * quad;
#pragma unroll
                for (int t_ = 0; t_ < 4; ++t_) {
                    { const int s0_ = 16 * t_ + 4 * quad; const u32x2 kx_ = TRR(lds + tlb + (s0_ + (l15 >> 2)) * SQB + (16 * w + 4 * (l15 & 3)) * 2);
                      kcf[4 * t_ + 0] = 1.0f - __expf(bflo(kx_.x)); kcf[4 * t_ + 1] = 1.0f - __expf(bfhi(kx_.x)); kcf[4 * t_ + 2] = 1.0f - __expf(bflo(kx_.y)); kcf[4 * t_ + 3] = 1.0f - __expf(bfhi(kx_.y)); }
                    if (FULL) { qc[t_] = *(const LAS u32x2*)(lds + L_TQ + (16 * t_ + l15) * SQB + TCOL(16 * t_ + l15, kq_) * 2); kc4[t_] = *(const LAS u32x2*)(lds + tlb + (16 * t_ + l15) * SQB + kq_ * 2); }
                }
            }
            f32x4 aC[4], alC, aR[4], alR, r0 = Z4, r1 = Z4;
            {
                const f32x4 X = MF(ONES, LF0, Z4);
                aC[0] = MF(M0, LF0, Z4); aC[1] = MF(M1, LF0, Z4); aC[2] = MF(M0, LF1, X); aC[3] = MF(M1, LF1, X); alC = MF(ONES, LF1, X);
                const f32x4 Y = MF(LF0, ONES, Z4);
                alR = MF(LF1, ONES, Y);
                if (FULL) { aR[0] = MF(LF0, M0, Z4); aR[1] = MF(LF0, M1, Z4); aR[2] = MF(LF1, M0, Y); aR[3] = MF(LF1, M1, Y); r0 = MF(LF0, SEL, Z4); r1 = MF(LF1, SEL, Y); }
            }
            bf16x8 KdA[2];
            {
                float kd[16];
#pragma unroll
                for (int tt = 0; tt < 4; ++tt)
#pragma unroll
                    for (int j = 0; j < 4; ++j) kd[4 * tt + j] = kcf[4 * tt + j] * __expf(alC[j] - aC[tt][j]);
                u32x4 p0, p1;
                p0.x = cvt_pk_bf16(kd[0], kd[1]); p0.y = cvt_pk_bf16(kd[2], kd[3]); p0.z = cvt_pk_bf16(kd[4], kd[5]); p0.w = cvt_pk_bf16(kd[6], kd[7]);
                p1.x = cvt_pk_bf16(kd[8], kd[9]); p1.y = cvt_pk_bf16(kd[10], kd[11]); p1.z = cvt_pk_bf16(kd[12], kd[13]); p1.w = cvt_pk_bf16(kd[14], kd[15]);
                KdA[0] = __builtin_bit_cast(bf16x8, p0); KdA[1] = __builtin_bit_cast(bf16x8, p1);
            }
            f32x4 dk;
#pragma unroll
            for (int j = 0; j < 4; ++j) dk[j] = __expf(alR[j]);
            sumal = sumal + alR;
            if (FULL) {
                f32x4 er0, er1, c10;
#pragma unroll
                for (int j = 0; j < 4; ++j) { er0[j] = __expf(r0[j]); er1[j] = __expf(r1[j]); c10[j] = __expf(r1[j] - r0[j]); }
#pragma unroll
                for (int tt = 0; tt < 4; ++tt) {
                    const f32x4 rI = (tt < 2) ? r0 : r1, erI = (tt < 2) ? er0 : er1;
                    const float qf[4] = {bflo(qc[tt].x), bfhi(qc[tt].x), bflo(qc[tt].y), bfhi(qc[tt].y)}, kf[4] = {1.0f - __expf(bflo(kc4[tt].x)), 1.0f - __expf(bfhi(kc4[tt].x)), 1.0f - __expf(bflo(kc4[tt].y)), 1.0f - __expf(bfhi(kc4[tt].y))};
                    float qd[4], qt[4], kt[4], k1[4];
#pragma unroll
                    for (int j = 0; j < 4; ++j) { const float d = fminf(fmaxf(aR[tt][j] - rI[j], -80.f), 80.f);
                        qt[j] = qf[j] * __expf(d); qd[j] = qt[j] * erI[j]; kt[j] = kf[j] * __expf(-d); k1[j] = kt[j] * c10[j]; }
                    const int off = (16 * tt + l15) * SQB + (16 * w + 4 * quad) * 2;
                    u32x2 wq, wt, wk;
                    wq.x = cvt_pk_bf16(qd[0], qd[1]); wq.y = cvt_pk_bf16(qd[2], qd[3]); wt.x = cvt_pk_bf16(qt[0], qt[1]); wt.y = cvt_pk_bf16(qt[2], qt[3]); wk.x = cvt_pk_bf16(kt[0], kt[1]); wk.y = cvt_pk_bf16(kt[2], kt[3]);
                    *(LAS u32x2*)(lds + L_QD + off) = wq;
                    *(LAS u32x2*)(lds + L_QT + off) = wt;
                    if (tt < 2) { u32x2 w1; w1.x = cvt_pk_bf16(k1[0], k1[1]); w1.y = cvt_pk_bf16(k1[2], k1[3]);
                        *(LAS u32x2*)(lds + L_KT0 + off) = wk; *(LAS u32x2*)(lds + L_KT1 + off) = w1; }
                    else *(LAS u32x2*)(lds + L_KT1 + off) = wk;
                }
                LBAR();
            }
            const int ti = w >> 1, vh = w & 1;
#pragma unroll
            for (int v2 = 0; v2 < 8; ++v2) {
#pragma unroll
                for (int j = 0; j < 4; ++j) Sacc[v2][j] *= dk[j];
#pragma unroll
                for (int ks = 0; ks < 2; ++ks) { const LAS unsigned char* vp = lds + vtb + (32 * ks + 4 * quad + (l15 >> 2)) * SVR + (16 * v2 + 4 * (l15 & 3)) * 2;
                    const u32x2 v0 = TRR(vp), v1 = TRR(vp + 16 * SVR); const u32x4 vb = (u32x4){v0.x, v0.y, v1.x, v1.y};
                    Sacc[v2] = MF(KdA[ks], __builtin_bit_cast(bf16x8, vb), Sacc[v2]); }
            }
            if (FULL) {
                bf16x8 pa[2];
                {
                    f32x4 pT[4];
                    const LAS unsigned char* KT = (ti < 2) ? (lds + L_KT0) : (lds + L_KT1);
                    bf16x8 qf[4];
#pragma unroll
                    for (int ks = 0; ks < 4; ++ks) qf[ks] = *(const LAS bf16x8*)(lds + L_QT + (16 * ti + l15) * SQB + (8 * quad + 32 * ks) * 2);
#pragma unroll
                    for (int sj = 0; sj < 4; ++sj) {
                        bf16x8 kf[4];
#pragma unroll
                        for (int ks = 0; ks < 4; ++ks) kf[ks] = *(const LAS bf16x8*)(KT + (16 * sj + l15) * SQB + (8 * quad + 32 * ks) * 2);
                        pT[sj] = Z4;
#pragma unroll
                        for (int ks = 0; ks < 4; ++ks) pT[sj] = MF(kf[ks], qf[ks], pT[sj]);
                    }
#pragma unroll
                    for (int sj = 0; sj < 4; ++sj)
#pragma unroll
                        for (int j = 0; j < 4; ++j) { const bool keep = (sj < ti) || (sj == ti && 4 * quad + j <= l15); pT[sj][j] = keep ? pT[sj][j] : 0.f; }
#pragma unroll
                    for (int pp = 0; pp < 2; ++pp) { u32x4 x; x.x = cvt_pk_bf16(pT[2 * pp][0], pT[2 * pp][1]); x.y = cvt_pk_bf16(pT[2 * pp][2], pT[2 * pp][3]);
                        x.z = cvt_pk_bf16(pT[2 * pp + 1][0], pT[2 * pp + 1][1]); x.w = cvt_pk_bf16(pT[2 * pp + 1][2], pT[2 * pp + 1][3]); pa[pp] = __builtin_bit_cast(bf16x8, x); }
                }
#pragma unroll 2
                for (int i = 0; i < 4; ++i) { const int vt = 4 * vh + i;
                    f32x4 o = Z4;
#pragma unroll
                    for (int ks = 0; ks < 4; ++ks) { const bf16x8 qdf = *(const LAS bf16x8*)(lds + L_QD + (16 * ti + l15) * SQB + (8 * quad + 32 * ks) * 2);
                        const bf16x8 bfr = *(const LAS bf16x8*)(lds + L_ST + (16 * vt + l15) * SQB + (8 * quad + 32 * ks) * 2); o = MF(qdf, bfr, o); }
#pragma unroll
                    for (int pp = 0; pp < 2; ++pp) { const LAS unsigned char* vp = lds + vtb + (32 * pp + 4 * quad + (l15 >> 2)) * SVR + (16 * vt + 4 * (l15 & 3)) * 2;
                        const u32x2 v0 = TRR(vp), v1 = TRR(vp + 16 * SVR); const u32x4 vb = (u32x4){v0.x, v0.y, v1.x, v1.y};
                        o = MF(pa[pp], __builtin_bit_cast(bf16x8, vb), o); }
                    bf16_t* op = (bf16_t*)Ob + (rowbase + (size_t)c * CH + 16 * ti + 4 * quad) * D + colq + 16 * vt + l15;
                    const unsigned o01 = cvt_pk_bf16(o[0], o[1]), o23 = cvt_pk_bf16(o[2], o[3]);
                    op[0] = (bf16_t)(o01 & 0xffffu); op[(size_t)D] = (bf16_t)(o01 >> 16); op[(size_t)2 * D] = (bf16_t)(o23 & 0xffffu); op[(size_t)3 * D] = (bf16_t)(o23 >> 16);
                }
            }
            if (FULL) LBAR();
            if (FULL) {
#pragma unroll
                for (int v2 = 0; v2 < 8; ++v2) { u32x2 sw; sw.x = cvt_pk_bf16(Sacc[v2][0], Sacc[v2][1]); sw.y = cvt_pk_bf16(Sacc[v2][2], Sacc[v2][3]);
                    *(LAS u32x2*)(lds + L_ST + (16 * v2 + l15) * SQB + (16 * w + 4 * quad) * 2) = sw; }
            }
            S2_STORE(vtn, tln);
        }
        if (!FULL) {
            float* sl = SLOC + (size_t)(bh * NSEG + seg) * 128 * 128;
#pragma unroll
            for (int vt = 0; vt < 8; ++vt)
#pragma unroll
                for (int j = 0; j < 4; ++j) sl[(16 * w + 4 * quad + j) * 128 + 16 * vt + l15] = Sacc[vt][j];
            if (l15 == 0) { f32x4 pv;
#pragma unroll
                for (int j = 0; j < 4; ++j) pv[j] = __expf(sumal[j]);
                *(f32x4*)(PLOC + (size_t)(bh * NSEG + seg) * 128 + 16 * w + 4 * quad) = pv; }
        } else if (g == 0 && seg == NSEG - 1) {
#pragma unroll
            for (int vt = 0; vt < 8; ++vt)
#pragma unroll
                for (int j = 0; j < 4; ++j) sb[(16 * w + 4 * quad + j) * 128 + 16 * vt + l15] = Sacc[vt][j];
        }
        __syncthreads();
#undef S2_LOAD
#undef S2_STORE
#undef S2_LF
    }
}
#undef TCOL
#undef TRR
}


#define XB_TMO      128
#define XB_XCNT(j)  (256  + 64 * (j))
#define XB_XSUB(j)  (1280 + 64 * (j))
#define XB_XGEN(j)  (2304 + 64 * (j))
#define XB_TOP      3328
#define XB_TOPGEN   3392
#define XCD_BAR_WORDS 3456
#define XB_SPIN_CAP (1u << 22)
__device__ __forceinline__ unsigned xb_ld(unsigned* p)              { return __hip_atomic_load(p, __ATOMIC_RELAXED, __HIP_MEMORY_SCOPE_AGENT); }
__device__ __forceinline__ unsigned xb_add(unsigned* p, unsigned v) { return __hip_atomic_fetch_add(p, v, __ATOMIC_RELAXED, __HIP_MEMORY_SCOPE_AGENT); }
__device__ __forceinline__ unsigned xb_xcc_id() { return (unsigned)__builtin_amdgcn_s_getreg((3 << 11) | 20) & 0xFu; }
#define XB_SPIN(cond, bar) do { unsigned _sp = 0; while (cond) { __builtin_amdgcn_s_sleep(1); \
    if ((++_sp & 255u) == 0u) { if (xb_ld(&(bar)[XB_TMO])) break; if (_sp > XB_SPIN_CAP) { atomicAdd(&(bar)[XB_TMO], 1u); break; } } } } while (0)
struct XcdBarrier { unsigned* bar; unsigned x; volatile LAS unsigned* st; };
__device__ __forceinline__ XcdBarrier xcd_barrier_post(unsigned* bar, volatile LAS unsigned* st) {
    XcdBarrier b; b.bar = bar; b.x = xb_xcc_id(); b.st = st;
    if (threadIdx.x == 0) (void)xb_add(&bar[XB_XCNT(b.x)], 1u);
    return b;
}
__device__ __forceinline__ void xcd_barrier_complete(unsigned* bar, unsigned x, unsigned& nloc, unsigned& nx) {
    const unsigned G = gridDim.x * gridDim.y * gridDim.z;
    unsigned sum, cnt, mine, sp = 0u;
    for (;;) {
        sum = 0u; cnt = 0u; mine = 0u;
#pragma unroll
        for (unsigned j = 0; j < 16; ++j) { const unsigned c = xb_ld(&bar[XB_XCNT(j)]); sum += c; cnt += (c > 0u) ? 1u : 0u; mine = (j == x) ? c : mine; }
        if (sum == G) break;
        __builtin_amdgcn_s_sleep(1);
        if ((++sp & 255u) == 0u) { if (xb_ld(&bar[XB_TMO])) break; if (sp > XB_SPIN_CAP) { atomicAdd(&bar[XB_TMO], 1u); break; } }
    }
    nloc = mine > 0u ? mine : 1u; nx = cnt > 0u ? cnt : 1u;
}
__device__ __forceinline__ void xcd_barrier(const XcdBarrier& b) {
    asm volatile("s_waitcnt vmcnt(0)" ::: "memory");
    __syncthreads();
    if (threadIdx.x == 0) {
        unsigned* bar = b.bar;
        __builtin_amdgcn_s_waitcnt(0);
        unsigned nloc = b.st[0], nx = b.st[1];
        if (nloc == 0u) { xcd_barrier_complete(bar, b.x, nloc, nx); b.st[0] = nloc; b.st[1] = nx; }
        const unsigned old = xb_add(&bar[XB_XSUB(b.x)], 1u);
        const unsigned gen = old / nloc;
        if (old + 1u == (gen + 1u) * nloc) {
            __builtin_amdgcn_fence(__ATOMIC_RELEASE, "agent");
            asm volatile("s_waitcnt vmcnt(0)" ::: "memory");
            const unsigned og = xb_add(&bar[XB_TOP], 1u);
            const unsigned tg = og / nx;
            if (og + 1u == (tg + 1u) * nx) xb_add(&bar[XB_TOPGEN], 1u);
            else XB_SPIN(xb_ld(&bar[XB_TOPGEN]) == tg, bar);
            __builtin_amdgcn_fence(__ATOMIC_ACQUIRE, "agent");
            xb_add(&bar[XB_XGEN(b.x)], 1u);
            asm volatile("s_waitcnt vmcnt(0)" ::: "memory");
        } else {
            XB_SPIN(xb_ld(&bar[XB_XGEN(b.x)]) == gen, bar);
            __builtin_amdgcn_fence(__ATOMIC_ACQUIRE, "agent");
            asm volatile("s_waitcnt vmcnt(0)" ::: "memory");
        }
    }
    __syncthreads();
}

__global__ void __launch_bounds__(NTHREADS, 2) fwd_megakernel(Args a) {
    extern __shared__ __attribute__((aligned(16))) unsigned char lds_raw[];
    LAS unsigned char* lds = (LAS unsigned char*)lds_raw;
    cg::grid_group grid = cg::this_grid();
    if (threadIdx.x < 16) ((LAS unsigned*)(lds + MISC_OFF))[threadIdx.x] = 0u;
    __syncthreads();
    const XcdBarrier xbar = xcd_barrier_post((unsigned*)(a.ws + WS_CTL), (volatile LAS unsigned*)(lds + MISC_OFF));
    grid.sync();
    for (int i = 0; i < 17; ++i) a.in[i] = as_global(a.in[i]);
    a.out = as_global(a.out); a.ws = as_global(a.ws);
    const float* ng = a.in[I_NG];
    float* out = a.out;
#define GSYNC() xcd_barrier(xbar)
#define WSP(off) (cx.ws + (off))
#define ADA ((const float*)WSP(WS_ADA))

    { const Ctx cx = mkctx(a.ws); p0_prologue(a, lds, cx); }
    GSYNC();
    { const Ctx cx = mkctx(a.ws); normmod_phase(a.in[I_X], ng + 0 * D, ADA, 0, 1, (bf16_t*)WSP(WS_H1), cx); }
    GSYNC();
    { const Ctx cx = mkctx(a.ws); pg8::Gemm g{(const bf16_t*)WSP(WS_H1), (const bf16_t*)WSP(WS_W1IN), M, 2 * FF, D}; pg8::StaticOrder S; S.init(M, 2 * FF, cx.G, cx.bid);
      pg8::EpiSwiGLU E{(bf16_t*)WSP(WS_ACT1), FF}; pg8::gemm_phase(lds, g, S, E, cx.tid); }
    GSYNC();
    { const Ctx cx = mkctx(a.ws); pg8::Gemm g{(const bf16_t*)WSP(WS_ACT1), (const bf16_t*)WSP(WS_W1OUT), M, D, FF}; pg8::StaticOrder S; S.init(M, D, cx.G, cx.bid);
      pg8::EpiStore E{(bf16_t*)WSP(WS_Y1), D}; pg8::gemm_phase(lds, g, S, E, cx.tid); }
    GSYNC();
    { const Ctx cx = mkctx(a.ws); res_phase<true, false, true, false, true>((const bf16_t*)WSP(WS_Y1), a.in[I_X], WSP(WS_XB), 0.5f, ADA, 2, ng + 1 * D, ng + 2 * D, 3, 4, (bf16_t*)WSP(WS_H2), cx); }
    GSYNC();
    for (int g = 0; g < NG; ++g) {
        { const Ctx cx = mkctx(a.ws); bf16_t* H2g = (bf16_t*)WSP(WS_H2) + (size_t)g * MG * D;
          pg8::Gemm gm{H2g, (const bf16_t*)WSP(WS_WMIX), MG, NMIX, D}; pg8::StaticOrder S; S.init(MG, NMIX, cx.G, cx.bid);
          pg8::EpiMix E{(bf16_t*)WSP(WS_CB), (bf16_t*)WSP(WS_P), (bf16_t*)WSP(WS_Q), (bf16_t*)WSP(WS_LF), (bf16_t*)WSP(WS_V), (bf16_t*)WSP(WS_GS), (bf16_t*)WSP(WS_SA), (bf16_t*)WSP(WS_SB),
                        (const float*)WSP(WS_LB), (bf16_t*)WSP(WS_KK)};
          pg8::gemm_phase(lds, gm, S, E, cx.tid); }
        GSYNC();
        { const Ctx cx = mkctx(a.ws); conv_phase((bf16_t*)WSP(WS_CB), (const bf16_t*)WSP(WS_P), (bf16_t*)WSP(WS_HALO), a.in[I_CONVW], a.in[I_CONVB], g, cx); }
        { const Ctx cx = mkctx(a.ws); float* sloc = (float*)((bf16_t*)WSP(WS_H2) + (size_t)g * MG * D);
          scan2::scan_pass<false>(lds, (const bf16_t*)WSP(WS_Q), (const bf16_t*)WSP(WS_LF), (const bf16_t*)WSP(WS_KK), (const bf16_t*)WSP(WS_V), (float*)WSP(WS_O), (float*)WSP(WS_SBUF), sloc, (float*)WSP(WS_PLOC), g, cx); }
        GSYNC();
        { const Ctx cx = mkctx(a.ws); float* sloc = (float*)((bf16_t*)WSP(WS_H2) + (size_t)g * MG * D);
          scan2::scan_pass<true>(lds, (const bf16_t*)WSP(WS_Q), (const bf16_t*)WSP(WS_LF), (const bf16_t*)WSP(WS_KK), (const bf16_t*)WSP(WS_V), (float*)WSP(WS_O), (float*)WSP(WS_SBUF), sloc, (float*)WSP(WS_PLOC), g, cx); }
        GSYNC();
        { const Ctx cx = mkctx(a.ws); og_phase((const float*)WSP(WS_O), (const bf16_t*)WSP(WS_GS), a.in[I_HGG], (bf16_t*)WSP(WS_Q), cx); }
        GSYNC();
        { const Ctx cx = mkctx(a.ws); pg8::Gemm gm{(const bf16_t*)WSP(WS_CB), (const bf16_t*)WSP(WS_WCO), MG, D, D}; pg8::StaticOrder S; S.init(MG, D, cx.G, cx.bid);
          pg8::EpiGate<0> E{(bf16_t*)WSP(WS_SA), (const bf16_t*)WSP(WS_SB)}; pg8::gemm_phase(lds, gm, S, E, cx.tid); }
        { const Ctx cx = mkctx(a.ws); pg8::Gemm gm{(const bf16_t*)WSP(WS_Q), (const bf16_t*)WSP(WS_WHO), MG, D, D}; pg8::StaticOrder S; S.init(MG, D, cx.G, cx.bid);
          pg8::EpiGate<1> E{(bf16_t*)WSP(WS_SA), (const bf16_t*)WSP(WS_SB)}; pg8::gemm_phase(lds, gm, S, E, cx.tid); }
        GSYNC();
        { const Ctx cx = mkctx(a.ws); bf16_t* H2g = (bf16_t*)WSP(WS_H2) + (size_t)g * MG * D;
          pg8::Gemm gm{(const bf16_t*)WSP(WS_SA), (const bf16_t*)WSP(WS_WMO), MG, D, D}; pg8::StaticOrder S; S.init(MG, D, cx.G, cx.bid);
          pg8::EpiStore E{H2g, D}; pg8::gemm_phase(lds, gm, S, E, cx.tid); }
        GSYNC();
    }
    { const Ctx cx = mkctx(a.ws); res_phase<true, true, false, true, true>((const bf16_t*)WSP(WS_H2), WSP(WS_XB), WSP(WS_XB), 1.0f, ADA, 5, ng + 3 * D, ng + 4 * D, 6, 7, (bf16_t*)WSP(WS_H3), cx); }
    GSYNC();
    { const Ctx cx = mkctx(a.ws); pg8::Gemm g{(const bf16_t*)WSP(WS_H3), (const bf16_t*)WSP(WS_W2IN), M, 2 * FF, D}; pg8::StaticOrder S; S.init(M, 2 * FF, cx.G, cx.bid);
      pg8::EpiSwiGLU E{(bf16_t*)WSP(WS_ACT2), FF}; pg8::gemm_phase(lds, g, S, E, cx.tid); }
    GSYNC();
    { const Ctx cx = mkctx(a.ws); pg8::Gemm g{(const bf16_t*)WSP(WS_ACT2), (const bf16_t*)WSP(WS_W2OUT), M, D, FF}; pg8::StaticOrder S; S.init(M, D, cx.G, cx.bid);
      pg8::EpiStore E{(bf16_t*)WSP(WS_Y2), D}; pg8::gemm_phase(lds, g, S, E, cx.tid); }
    GSYNC();
    { const Ctx cx = mkctx(a.ws); res_phase<false, false, false, true, false>((const bf16_t*)WSP(WS_Y2), WSP(WS_XB), out, 0.5f, ADA, 8, ng + 5 * D, nullptr, 0, 0, nullptr, cx); }
#undef GSYNC
}

extern "C" void kernel_launch(void* const* d_in, const int* in_sizes, int n_in, void* d_out, int out_size, void* d_ws, size_t ws_size, hipStream_t stream) {
    static int grid = 0;
    if (grid == 0) {
        if (n_in != 17 || in_sizes[0] != M * D || out_size != M * D || ws_size < WS_END) {
            fprintf(stderr, "kernel_launch: unexpected shapes (n_in %d, in0 %d, out %d, ws %zu)\n", n_in, n_in > 0 ? in_sizes[0] : -1, out_size, ws_size); grid = -1; return; }
        int dev = 0, cus = 0, per_cu = 0;
        if (hipGetDevice(&dev) != hipSuccess || hipDeviceGetAttribute(&cus, hipDeviceAttributeMultiprocessorCount, dev) != hipSuccess) { grid = -1; return; }
        if (hipFuncSetAttribute((const void*)fwd_megakernel, hipFuncAttributeMaxDynamicSharedMemorySize, LDS_BYTES) != hipSuccess) { fprintf(stderr, "kernel_launch: hipFuncSetAttribute failed\n"); grid = -1; return; }
        if (hipOccupancyMaxActiveBlocksPerMultiprocessor(&per_cu, (const void*)fwd_megakernel, NTHREADS, LDS_BYTES) != hipSuccess || per_cu < 1) { fprintf(stderr, "kernel_launch: occupancy query says %d\n", per_cu); per_cu = 1; }
        (void)hipGetLastError();
        grid = cus * 1;
        if (grid > 256) grid = 256;
    }
    if (grid < 0) return;
    if (hipMemsetAsync((char*)d_ws + WS_CTL, 0, CTL_BYTES, stream) != hipSuccess) { fprintf(stderr, "kernel_launch: memset failed\n"); return; }
    Args a{};
    for (int i = 0; i < 17; ++i) a.in[i] = (const float*)d_in[i];
    a.out = (float*)d_out; a.ws = (unsigned char*)d_ws;
    void* args[] = {&a};
    hipError_t e = hipLaunchCooperativeKernel((const void*)fwd_megakernel, dim3(grid), dim3(NTHREADS), args, LDS_BYTES, stream);
    if (e != hipSuccess) fprintf(stderr, "kernel_launch: cooperative launch failed: %s (grid %d)\n", hipGetErrorString(e), grid);
}
```
